# Optimizing an MI355X kernel written in HIP

```python
import math
import jax
import jax.numpy as jnp
from jax import lax
import numpy as np

D_MODEL = 1024
BATCH = 8
SEQ = 8192
DEPTH = 2

GRID_W = 64
CTX_LEN = 256
N_EVEN = (DEPTH + 1) // 2
N_ODD = DEPTH // 2
N_MOD = 9
D_FF = 2816
FFN_RES = 0.5
EPS = 1e-6
ROPE_BASE = 10000.0
Q_BLOCK = 128
NEG_INF = -1e30

MLA_HEADS = 8
MLA_Q_LORA = 256
MLA_KV_LORA = 128
MLA_NOPE = 64
MLA_ROPE = 32
MLA_V = 64
MLA_SCALE = (MLA_NOPE + MLA_ROPE) ** -0.5

SWA_HEADS = 8
SWA_KV_HEADS = 2
SWA_GROUP = SWA_HEADS // SWA_KV_HEADS
SWA_HEAD_DIM = 64
SWA_WINDOW = 128
SWA_SCALE = SWA_HEAD_DIM ** -0.5

ATTN_IN = MLA_Q_LORA + MLA_KV_LORA + MLA_ROPE + (SWA_HEADS + 2 * SWA_KV_HEADS) * SWA_HEAD_DIM
ATTN_OUT = MLA_HEADS * MLA_V + SWA_HEADS * SWA_HEAD_DIM

S5_WIDTH = D_MODEL
S5_GROUP = 16
S5_GROUPS = S5_WIDTH // S5_GROUP
S5_STATE = 64
S5_CHUNK = 128
S5_MAX_RE = -1e-4

kernel_name = 'hybrid_mla_swa_s5_macaron_dit'


def rmsnorm(x, g):
    xf = x.astype(jnp.float32)
    y = xf * lax.rsqrt(jnp.mean(xf * xf, axis=-1, keepdims=True) + EPS)
    return (y * g.astype(jnp.float32)).astype(x.dtype)


def modulate(h, g, shift, scale):
    return rmsnorm(h, g) * (1 + scale) + shift


def swiglu(h, w13, w2):
    gate, up = jnp.split(h @ w13, 2, axis=-1)
    return (jax.nn.silu(gate) * up) @ w2


def ffn_sublayer(h, m, j, g_pre, g_post, w13, w2):
    a = modulate(h, g_pre, m[3 * j], m[3 * j + 1])
    return h + FFN_RES * m[3 * j + 2] * rmsnorm(swiglu(a, w13, w2), g_post)


def axial_rope_table(rows, cols, d_rot):
    d_axis = d_rot // 2
    inv = ROPE_BASE ** (-jnp.arange(0, d_axis, 2, dtype=jnp.float32) / d_axis)
    ang = jnp.concatenate([rows.astype(jnp.float32)[:, None] * inv,
                           cols.astype(jnp.float32)[:, None] * inv], axis=-1)
    return jnp.cos(ang), jnp.sin(ang)


def apply_rope(x, table):
    cos, sin = table
    bshape = cos.shape[:1] + (1,) * (x.ndim - 3) + cos.shape[1:]
    cos = cos.reshape(bshape).astype(x.dtype)
    sin = sin.reshape(bshape).astype(x.dtype)
    x1, x2 = jnp.split(x, 2, axis=-1)
    return jnp.concatenate([x1 * cos - x2 * sin, x1 * sin + x2 * cos], axis=-1)


def to_blocks(t):
    b, s = t.shape[:2]
    return jnp.moveaxis(t.reshape((b, s // Q_BLOCK, Q_BLOCK) + t.shape[2:]), 1, 0)


def from_blocks(t):
    t = jnp.moveaxis(t, 0, 1)
    return t.reshape((t.shape[0], t.shape[1] * t.shape[2]) + t.shape[3:])


def softmax_attention(q, k, v, scale):
    s = jnp.einsum('bqhd,bkhd->bhqk', q, k, preferred_element_type=jnp.float32) * scale
    p = jax.nn.softmax(s, axis=-1).astype(v.dtype)
    return jnp.einsum('bhqk,bkhd->bqhd', p, v)


def sink_attention(q, k, v, sink, mask):
    s = jnp.einsum('bqkgd,bjkd->bkgqj', q, k, preferred_element_type=jnp.float32) * SWA_SCALE
    if mask is not None:
        s = jnp.where(mask, s, NEG_INF)
    sink_col = jnp.broadcast_to(sink.astype(jnp.float32)[None, :, :, None, None], s.shape[:-1] + (1,))
    p = jax.nn.softmax(jnp.concatenate([sink_col, s], axis=-1), axis=-1)[..., 1:]
    return jnp.einsum('bkgqj,bjkd->bqkgd', p.astype(v.dtype), v)


def attn_project(h, w_in, q_norm, w_uq, kv_norm, w_ukv, rope_a, rope_b):
    b, n = h.shape[:2]
    sizes = [MLA_Q_LORA, MLA_KV_LORA, MLA_ROPE, SWA_HEADS * SWA_HEAD_DIM, SWA_KV_HEADS * SWA_HEAD_DIM]
    cuts = [int(v) for v in np.cumsum(sizes)]
    cq, ckv, kpe, qs, ks, vs = jnp.split(h @ w_in, cuts, axis=-1)
    q = (rmsnorm(cq, q_norm) @ w_uq).reshape(b, n, MLA_HEADS, MLA_NOPE + MLA_ROPE)
    kv = (rmsnorm(ckv, kv_norm) @ w_ukv).reshape(b, n, MLA_HEADS, MLA_NOPE + MLA_V)
    q_nope, q_pe = q[..., :MLA_NOPE], q[..., MLA_NOPE:]
    k_nope, v_a = kv[..., :MLA_NOPE], kv[..., MLA_NOPE:]
    k_pe = kpe.reshape(b, n, 1, MLA_ROPE)
    q_s = qs.reshape(b, n, SWA_KV_HEADS, SWA_GROUP, SWA_HEAD_DIM)
    k_s = ks.reshape(b, n, SWA_KV_HEADS, SWA_HEAD_DIM)
    v_s = vs.reshape(b, n, SWA_KV_HEADS, SWA_HEAD_DIM)
    if rope_a is not None:
        q_pe = apply_rope(q_pe, rope_a)
        k_pe = apply_rope(k_pe, rope_a)
        q_s = apply_rope(q_s, rope_b)
        k_s = apply_rope(k_s, rope_b)
    q_a = jnp.concatenate([q_nope, q_pe], axis=-1)
    k_a = jnp.concatenate([k_nope, jnp.broadcast_to(k_pe, (b, n, MLA_HEADS, MLA_ROPE))], axis=-1)
    return q_a, k_a, v_a, q_s, k_s, v_s


def attn_mixer(h_ctx, h_lat, rope_a, rope_b, w_in, q_norm, w_uq, kv_norm, w_ukv, sink, w_out, ctx_out):
    qa_c, ka_c, va_c, qs_c, ks_c, vs_c = attn_project(h_ctx, w_in, q_norm, w_uq, kv_norm, w_ukv, None, None)
    qa_l, ka_l, va_l, qs_l, ks_l, vs_l = attn_project(h_lat, w_in, q_norm, w_uq, kv_norm, w_ukv, rope_a, rope_b)
    b, n = h_lat.shape[:2]
    n_ctx = h_ctx.shape[1]
    sink_kg = sink.reshape(SWA_KV_HEADS, SWA_GROUP)
    k_all = jnp.concatenate([ka_c, ka_l], axis=1)
    v_all = jnp.concatenate([va_c, va_l], axis=1)
    o_a = from_blocks(lax.map(lambda qb: softmax_attention(qb, k_all, v_all, MLA_SCALE), to_blocks(qa_l)))
    pad = ((0, 0), (SWA_WINDOW, SWA_WINDOW), (0, 0), (0, 0))
    k_pad = jnp.pad(ks_l, pad)
    v_pad = jnp.pad(vs_l, pad)
    span = Q_BLOCK + 2 * SWA_WINDOW

    def swa_block(args):
        i, qb = args
        start = i * Q_BLOCK
        k_loc = lax.dynamic_slice_in_dim(k_pad, start, span, axis=1)
        v_loc = lax.dynamic_slice_in_dim(v_pad, start, span, axis=1)
        q_pos = start + jnp.arange(Q_BLOCK)
        k_pos = start - SWA_WINDOW + jnp.arange(span)
        band = (jnp.abs(q_pos[:, None] - k_pos[None, :]) <= SWA_WINDOW) & (k_pos >= 0)[None, :] & (k_pos < n)[None, :]
        mask = jnp.concatenate([jnp.ones((Q_BLOCK, n_ctx), dtype=bool), band], axis=1)
        return sink_attention(qb, jnp.concatenate([ks_c, k_loc], axis=1),
                              jnp.concatenate([vs_c, v_loc], axis=1), sink_kg, mask)

    o_b = from_blocks(lax.map(swa_block, (jnp.arange(n // Q_BLOCK), to_blocks(qs_l))))
    y_lat = jnp.concatenate([o_a.reshape(b, n, -1), o_b.reshape(b, n, -1)], axis=-1) @ w_out
    y_ctx = None
    if ctx_out:
        o_a_c = softmax_attention(qa_c, ka_c, va_c, MLA_SCALE)
        o_b_c = sink_attention(qs_c, ks_c, vs_c, sink_kg, None)
        y_ctx = jnp.concatenate([o_a_c.reshape(b, n_ctx, -1), o_b_c.reshape(b, n_ctx, -1)], axis=-1) @ w_out
    return y_ctx, y_lat


def s5_discretise(lam_re, lam_im, b_re, b_im, log_step):
    lam_re = jnp.minimum(lam_re, S5_MAX_RE)
    dt = jnp.exp(log_step)[:, None]
    mag = jnp.exp(lam_re * dt)
    a_re = mag * jnp.cos(lam_im * dt)
    a_im = mag * jnp.sin(lam_im * dt)
    den = lam_re * lam_re + lam_im * lam_im
    f_re = ((a_re - 1.0) * lam_re + a_im * lam_im) / den
    f_im = (a_im * lam_re - (a_re - 1.0) * lam_im) / den
    bb_re = f_re[..., None] * b_re - f_im[..., None] * b_im
    bb_im = f_re[..., None] * b_im + f_im[..., None] * b_re
    return a_re, a_im, bb_re, bb_im


def complex_affine_combine(e1, e2):
    a1r, a1i, b1r, b1i = e1
    a2r, a2i, b2r, b2i = e2
    return (a2r * a1r - a2i * a1i, a2r * a1i + a2i * a1r,
            a2r * b1r - a2i * b1i + b2r, a2r * b1i + a2i * b1r + b2i)


def s5_scan(u, a_re, a_im, bb_re, bb_im, c_re, c_im, h_re, h_im, emit):
    b, n = u.shape[:2]
    chunks = jnp.moveaxis(u.reshape(b, n // S5_CHUNK, S5_CHUNK, S5_GROUPS, S5_GROUP), 1, 0)

    def step(carry, u_c):
        hr, hi = carry
        bu_re = jnp.einsum('blgh,gph->blgp', u_c, bb_re)
        bu_im = jnp.einsum('blgh,gph->blgp', u_c, bb_im)
        ar = jnp.broadcast_to(a_re, bu_re.shape)
        ai = jnp.broadcast_to(a_im, bu_re.shape)
        pa_re, pa_im, s_re, s_im = lax.associative_scan(complex_affine_combine, (ar, ai, bu_re, bu_im), axis=1)
        x_re = s_re + pa_re * hr[:, None] - pa_im * hi[:, None]
        x_im = s_im + pa_re * hi[:, None] + pa_im * hr[:, None]
        new = (x_re[:, -1], x_im[:, -1])
        if not emit:
            return new, None
        y = jnp.einsum('blgp,ghp->blgh', x_re, c_re) - jnp.einsum('blgp,ghp->blgh', x_im, c_im)
        return new, y

    h_end, ys = lax.scan(step, (h_re, h_im), chunks)
    y = jnp.moveaxis(ys, 0, 1).reshape(b, n, S5_WIDTH) if emit else None
    return y, h_end


def s5_mixer(h_ctx, h_lat, w_in, lam_re, lam_im, b_re, b_im, c_re, c_im, log_step, d_skip, w_glu, ctx_out):
    f32 = jnp.float32
    b = h_lat.shape[0]
    u_ctx = (h_ctx @ w_in).astype(f32)
    u_lat = (h_lat @ w_in).astype(f32)
    dsk = d_skip.astype(f32)
    y_lat = u_lat * dsk
    y_ctx = u_ctx * dsk if ctx_out else None
    for dr in range(2):
        a_re, a_im, bb_re, bb_im = s5_discretise(lam_re[dr].astype(f32), lam_im[dr].astype(f32),
                                                 b_re[dr].astype(f32), b_im[dr].astype(f32),
                                                 log_step[dr].astype(f32))
        cr = c_re[dr].astype(f32)
        ci = c_im[dr].astype(f32)
        uc = u_ctx.reshape(b, -1, S5_GROUPS, S5_GROUP)
        ul = u_lat.reshape(b, -1, S5_GROUPS, S5_GROUP)
        if dr == 1:
            uc, ul = uc[:, ::-1], ul[:, ::-1]
        zero = jnp.zeros((b, S5_GROUPS, S5_STATE), f32)
        yc, h_ctx_end = s5_scan(uc, a_re, a_im, bb_re, bb_im, cr, ci, zero, zero, ctx_out)
        yl, _ = s5_scan(ul, a_re, a_im, bb_re, bb_im, cr, ci, h_ctx_end[0], h_ctx_end[1], True)
        if dr == 1:
            yl = yl[:, ::-1]
            yc = yc[:, ::-1] if ctx_out else None
        y_lat = y_lat + yl
        if ctx_out:
            y_ctx = y_ctx + yc

    def glu_out(y):
        a, g = jnp.split(jax.nn.gelu(y).astype(h_lat.dtype) @ w_glu, 2, axis=-1)
        return a * jax.nn.sigmoid(g)

    return (glu_out(y_ctx) if ctx_out else None), glu_out(y_lat)


def setup_inputs(seed: int = 0) -> dict:
    key = jax.random.key(seed)
    keys = iter(jax.random.split(key, 32))
    f32 = jnp.float32

    def nrm(shape, scale):
        return scale * jax.random.normal(next(keys), shape, f32)

    def gain(shape):
        return 1.0 + 0.01 * jax.random.normal(next(keys), shape, f32)

    G, P, H = S5_GROUPS, S5_STATE, S5_GROUP
    inp = {}
    inp['x'] = nrm((BATCH, SEQ, D_MODEL), 1.0)
    inp['c'] = nrm((BATCH, D_MODEL), 1.0)
    inp['ctx'] = nrm((BATCH, CTX_LEN, D_MODEL), 1.0)
    inp['c_ctx'] = nrm((D_MODEL,), 1.0)
    inp['mod_w'] = nrm((DEPTH, D_MODEL, N_MOD * D_MODEL), D_MODEL ** -0.5)
    inp['mod_b'] = nrm((DEPTH, N_MOD * D_MODEL), 0.01)
    inp['norm_pre'] = gain((DEPTH, 3, D_MODEL))
    inp['norm_post'] = gain((DEPTH, 3, D_MODEL))
    inp['ffn_w13'] = nrm((DEPTH, 2, D_MODEL, 2 * D_FF), D_MODEL ** -0.5)
    inp['ffn_w2'] = nrm((DEPTH, 2, D_FF, D_MODEL), D_FF ** -0.5)
    inp['attn_w_in'] = nrm((N_EVEN, D_MODEL, ATTN_IN), D_MODEL ** -0.5)
    inp['mla_q_norm'] = gain((N_EVEN, MLA_Q_LORA))
    inp['mla_w_uq'] = nrm((N_EVEN, MLA_Q_LORA, MLA_HEADS * (MLA_NOPE + MLA_ROPE)), MLA_Q_LORA ** -0.5)
    inp['mla_kv_norm'] = gain((N_EVEN, MLA_KV_LORA))
    inp['mla_w_ukv'] = nrm((N_EVEN, MLA_KV_LORA, MLA_HEADS * (MLA_NOPE + MLA_V)), MLA_KV_LORA ** -0.5)
    inp['swa_sink'] = nrm((N_EVEN, SWA_HEADS), 0.5)
    inp['attn_w_out'] = nrm((N_EVEN, ATTN_OUT, D_MODEL), ATTN_OUT ** -0.5)
    inp['s5_w_in'] = nrm((N_ODD, D_MODEL, S5_WIDTH), D_MODEL ** -0.5)
    inp['s5_lambda_re'] = -0.5 + nrm((N_ODD, 2, G, P), 0.01)
    inp['s5_lambda_im'] = np.pi * jnp.arange(P, dtype=f32) + nrm((N_ODD, 2, G, P), 0.01)
    inp['s5_b_re'] = nrm((N_ODD, 2, G, P, H), (2 * H) ** -0.5)
    inp['s5_b_im'] = nrm((N_ODD, 2, G, P, H), (2 * H) ** -0.5)
    inp['s5_c_re'] = nrm((N_ODD, 2, G, H, P), (2 * P) ** -0.5)
    inp['s5_c_im'] = nrm((N_ODD, 2, G, H, P), (2 * P) ** -0.5)
    inp['s5_log_step'] = jax.random.uniform(next(keys), (N_ODD, 2, G), f32, math.log(1e-3), math.log(1e-1))
    inp['s5_d'] = nrm((N_ODD, S5_WIDTH), 1.0)
    inp['s5_w_glu'] = nrm((N_ODD, S5_WIDTH, 2 * D_MODEL), S5_WIDTH ** -0.5)
    return inp


def reference(x, c, ctx, c_ctx, mod_w, mod_b, norm_pre, norm_post, ffn_w13, ffn_w2,
              attn_w_in, mla_q_norm, mla_w_uq, mla_kv_norm, mla_w_ukv, swa_sink, attn_w_out,
              s5_w_in, s5_lambda_re, s5_lambda_im, s5_b_re, s5_b_im, s5_c_re, s5_c_im,
              s5_log_step, s5_d, s5_w_glu):
    b, n = x.shape[:2]
    ROWS = n // GRID_W
    rows = jnp.repeat(jnp.arange(ROWS), GRID_W)
    cols = jnp.tile(jnp.arange(GRID_W), ROWS)
    rope_a = axial_rope_table(rows, cols, MLA_ROPE)
    rope_b = axial_rope_table(rows, cols, SWA_HEAD_DIM)
    h_lat, h_ctx = x, ctx
    for l in range(DEPTH):
        last = l == DEPTH - 1
        m_lat = jnp.moveaxis((jax.nn.silu(c) @ mod_w[l] + mod_b[l]).reshape(b, N_MOD, 1, D_MODEL), 1, 0)
        m_ctx = (jax.nn.silu(c_ctx) @ mod_w[l] + mod_b[l]).reshape(N_MOD, 1, 1, D_MODEL)
        h_lat = ffn_sublayer(h_lat, m_lat, 0, norm_pre[l, 0], norm_post[l, 0], ffn_w13[l, 0], ffn_w2[l, 0])
        h_ctx = ffn_sublayer(h_ctx, m_ctx, 0, norm_pre[l, 0], norm_post[l, 0], ffn_w13[l, 0], ffn_w2[l, 0])
        a_lat = modulate(h_lat, norm_pre[l, 1], m_lat[3], m_lat[4])
        a_ctx = modulate(h_ctx, norm_pre[l, 1], m_ctx[3], m_ctx[4])
        if l % 2 == 0:
            e = l // 2
            y_ctx, y_lat = attn_mixer(a_ctx, a_lat, rope_a, rope_b, attn_w_in[e], mla_q_norm[e], mla_w_uq[e],
                                      mla_kv_norm[e], mla_w_ukv[e], swa_sink[e], attn_w_out[e], not last)
        else:
            o = l // 2
            y_ctx, y_lat = s5_mixer(a_ctx, a_lat, s5_w_in[o], s5_lambda_re[o], s5_lambda_im[o], s5_b_re[o],
                                    s5_b_im[o], s5_c_re[o], s5_c_im[o], s5_log_step[o], s5_d[o], s5_w_glu[o],
                                    not last)
        h_lat = h_lat + m_lat[5] * rmsnorm(y_lat, norm_post[l, 1])
        h_lat = ffn_sublayer(h_lat, m_lat, 2, norm_pre[l, 2], norm_post[l, 2], ffn_w13[l, 1], ffn_w2[l, 1])
        if not last:
            h_ctx = h_ctx + m_ctx[5] * rmsnorm(y_ctx, norm_post[l, 1])
            h_ctx = ffn_sublayer(h_ctx, m_ctx, 2, norm_pre[l, 2], norm_post[l, 2], ffn_w13[l, 1], ffn_w2[l, 1])
    return h_lat
```

```cpp
#include <hip/hip_runtime.h>
#include <hip/hip_cooperative_groups.h>
#include <cstdio>
#include <cstdint>
namespace cg = cooperative_groups;

#define LAS __attribute__((address_space(3)))
#define DI __device__ __forceinline__
typedef unsigned short bf16_t;
typedef short bf16x8 __attribute__((ext_vector_type(8)));
typedef short s16x4 __attribute__((ext_vector_type(4)));
typedef float f32x4 __attribute__((ext_vector_type(4)));
typedef float f32x16 __attribute__((ext_vector_type(16)));
typedef unsigned u32x4 __attribute__((ext_vector_type(4)));
typedef unsigned u32x2 __attribute__((ext_vector_type(2)));
typedef float f32x2_t __attribute__((ext_vector_type(2)));
typedef __bf16 bf16x2_t __attribute__((ext_vector_type(2)));

constexpr int D = 1024, FF = 2816, TL = 65536, TC = 2048, TA = TL + TC, SEQ = 8192, CTXN = 256, NBATCH = 8;
constexpr int PROJ_N = 1280, CN_N = 384, QKV_N = 1792, XE_K = 1280;
constexpr float EPSV = 1e-6f;
constexpr float LOG2E = 1.4426950408889634f;
constexpr size_t MiB = (size_t)1 << 20;
constexpr size_t WS_MOD = 1 * MiB, WS_ROPE = 2 * MiB, WS_ABAR = 3 * MiB, WS_BBAR = 4 * MiB, WS_POW = 5 * MiB, WS_KTAB = 10 * MiB, WS_SCTX = 18 * MiB;
constexpr size_t WS_W13T = 20 * MiB, WS_W2T = 64 * MiB, WS_WINT = 86 * MiB, WS_WUT = 89 * MiB, WS_WOUTT = 91 * MiB, WS_S5INT = 93 * MiB, WS_GLUT = 95 * MiB;
constexpr size_t WS_HCTX = 100 * MiB, WS_A = 108 * MiB, WS_Y = 240 * MiB, WS_SCR = 504 * MiB;
constexpr size_t WS_U = WS_SCR;
constexpr size_t WS_PROJ = WS_SCR, WS_CN = WS_SCR + 166 * MiB, WS_QKV = WS_SCR + 216 * MiB;
constexpr size_t WS_XE = WS_SCR, WS_UC = WS_SCR + 160 * MiB, WS_E = WS_SCR + 168 * MiB, WS_BM = WS_SCR + 232 * MiB, WS_BS = WS_SCR + 392 * MiB;
constexpr size_t WS_END = 1024 * MiB;
static_assert(WS_U + (size_t)TA * FF * 2 <= WS_END, "U");
static_assert(WS_PROJ + (size_t)TA * PROJ_N * 2 <= WS_CN && WS_CN + (size_t)TA * CN_N * 2 <= WS_QKV && WS_QKV + (size_t)TA * QKV_N * 2 <= WS_END, "attn scratch");
static_assert(WS_BS + (size_t)64 * 256 * 1024 * 2 <= WS_END && WS_BM + (size_t)64 * 1024 * XE_K * 2 <= WS_BS, "s5 scratch");
constexpr size_t WS_HB = 372 * MiB;
static_assert(WS_A + (size_t)TA * D * 2 <= WS_Y && WS_Y + (size_t)TA * D * 2 <= WS_HB && WS_HB + (size_t)TL * D * 2 <= WS_SCR, "A/Y/HB");
#ifndef PROBE_ATT
#define PROBE_ATT 1
#endif
#ifndef PROBE_PRO
#define PROBE_PRO 1
#endif
#ifndef PROBE_MISC
#define PROBE_MISC 1
#endif
#ifndef PROBE_SYNC
#define PROBE_SYNC 1
#endif
#ifndef PROBE_G1
#define PROBE_G1 1
#endif
#ifndef PROBE_G2
#define PROBE_G2 1
#endif
constexpr int LDS_BYTES = 147456;

#define GAS __attribute__((address_space(1)))
template <class T> DI T* gl(T* p) { return (T*)(GAS T*)p; }
DI unsigned f2bf(float f) { unsigned u = __builtin_bit_cast(unsigned, f); return (u + 0x7fffu + ((u >> 16) & 1u)) >> 16; }
DI unsigned cvtpk(float lo, float hi) { f32x2_t v = {lo, hi}; bf16x2_t b = __builtin_convertvector(v, bf16x2_t); return __builtin_bit_cast(unsigned, b); }
DI float bf2f(unsigned short b) { return __builtin_bit_cast(float, (unsigned)b << 16); }
DI float wave_sum(float v) {
    v += __builtin_bit_cast(float, __builtin_amdgcn_update_dpp(0, __builtin_bit_cast(int, v), 0xB1, 0xf, 0xf, true));
    v += __builtin_bit_cast(float, __builtin_amdgcn_update_dpp(0, __builtin_bit_cast(int, v), 0x4E, 0xf, 0xf, true));
    v += __builtin_bit_cast(float, __builtin_amdgcn_update_dpp(0, __builtin_bit_cast(int, v), 0x141, 0xf, 0xf, true));
    v += __builtin_bit_cast(float, __builtin_amdgcn_update_dpp(0, __builtin_bit_cast(int, v), 0x140, 0xf, 0xf, true));
    { auto rr = __builtin_amdgcn_permlane16_swap(__float_as_uint(v), __float_as_uint(v), false, false); v = __uint_as_float(rr[0]) + __uint_as_float(rr[1]); }
    { auto rr = __builtin_amdgcn_permlane32_swap(__float_as_uint(v), __float_as_uint(v), false, false); v = __uint_as_float(rr[0]) + __uint_as_float(rr[1]); }
    return v;
}
DI float sigm(float x) { return __builtin_amdgcn_rcpf(1.f + __expf(-x)); }
DI void sincos_rad_d(double ang, float& s, float& c) { double rev = ang * 0.15915494309189535; rev -= __builtin_rint(rev); const float f = (float)rev; s = __builtin_amdgcn_sinf(f); c = __builtin_amdgcn_cosf(f); }

namespace pg8 {
constexpr int BM = 256, BK = 64, HALF = 128, HTB = HALF * BK * 2, STAGE_BYTES = 8 * HTB, NXCD = 8, WGM = 8;
DI int lds_byte(int r, int c) { const int st = (r >> 4) * 2 + (c >> 5), rr = r & 15, cc = c & 31, ob = rr * 64 + cc * 2; return st * 1024 + (ob ^ (((ob >> 9) & 1) << 5)); }
DI void stage_rc(int b, int& R, int& C) { const int st = b / 1024, sb = b % 1024, swz = sb ^ (((sb >> 9) & 1) << 5); R = (st >> 1) * 16 + swz / 64; C = (st & 1) * 32 + (swz % 64) / 2; }
DI int perm32(int rho) { const int n = rho >> 4, i = rho & 15; return 8 * (i >> 2) + 4 * n + (i & 3); }
struct Unit { int pm, pn; };
struct Gemm { const bf16_t* A; const bf16_t* Bt; int M, N, K, lda, ldb, mt_per_group; size_t strideB; };
struct StaticOrder {
    int nM, nN, nwg, G, c;
    DI void init(int M, int N, int G_, int c_) { nM = M / BM; nN = N / BM; nwg = nM * nN; G = G_; c = c_; }
    DI bool next(int i, Unit& u) const {
        const long L = (long)i * G + c; if (L >= nwg) return false;
        int wgid = (int)L; { const int q = nwg / NXCD, r = nwg % NXCD, xcd = wgid % NXCD, off = wgid / NXCD; wgid = (xcd < r ? xcd * (q + 1) : r * (q + 1) + (xcd - r) * q) + off; }
        const int nig = WGM * nN, gid = wgid / nig, fm = gid * WGM, gsz = (nM - fm) < WGM ? (nM - fm) : WGM;
        u.pm = fm + ((wgid % nig) % gsz); u.pn = (wgid % nig) / gsz; return true;
    }
};
template <class Epi>
DI void gemm_phase(LAS unsigned char* lds, const Gemm g, const StaticOrder& S, const Epi& E) {
    int tid_ = threadIdx.x; asm volatile("" : "+v"(tid_));
    const int tid = tid_, wid = __builtin_amdgcn_readfirstlane(tid >> 6), lane = tid & 63, wr = wid >> 2, wc = wid & 3, fr = lane & 15, fq = lane >> 4;
    const int K = g.K, nt = K / BK;
    unsigned voffA[2], voffB[2];
#pragma unroll
    for (int i = 0; i < 2; ++i) { int R, C; stage_rc(tid * 16 + i * 8192, R, C); const int Rb = Epi::PERM ? ((R & ~31) + perm32(R & 31)) : R;
        voffA[i] = (unsigned)(R * g.lda + C) * 2u; voffB[i] = (unsigned)(Rb * g.ldb + C) * 2u; }
    const size_t kstep = (size_t)(BK * 2);
    const size_t hstepA = (size_t)HALF * g.lda * 2, hstepB = (size_t)HALF * g.ldb * 2, tstepA = 2 * hstepA, tstepB = 2 * hstepB;
    const unsigned ldsw = (unsigned)wid * 1024u;
    const int aoff = lds_byte(wr * 64 + fr, fq * 8), boff = lds_byte(wc * 32 + fr, fq * 8);
#define PG8_SA(b, h) (((b) * 2 + (h)) * HTB)
#define PG8_SB(b, h) ((4 + (b) * 2 + (h)) * HTB)
#define PG8_STAGE(bufoff, gbase, voff) do { _Pragma("unroll") for (int _i = 0; _i < 2; ++_i) \
        __builtin_amdgcn_global_load_lds((const unsigned*)((const char*)(gbase) + (voff)[_i]), (LAS unsigned*)(lds + (bufoff) + ldsw + _i * 8192), 16, 0, 0); } while (0)
#define PG8_LDA(dst, b, h) do { _Pragma("unroll") for (int m = 0; m < 4; ++m) _Pragma("unroll") for (int k = 0; k < 2; ++k) dst[m][k] = *(const LAS bf16x8*)(lds + PG8_SA(b, h) + aoff + m * 2048 + k * 1024); } while (0)
#define PG8_LDB(dst, b, h) do { _Pragma("unroll") for (int n = 0; n < 2; ++n) _Pragma("unroll") for (int k = 0; k < 2; ++k) dst[n][k] = *(const LAS bf16x8*)(lds + PG8_SB(b, h) + boff + n * 2048 + k * 1024); } while (0)
#define PG8_MMA(ai, bj, At, Bt) do { __builtin_amdgcn_s_setprio(1); _Pragma("unroll") for (int m = 0; m < 4; ++m) _Pragma("unroll") for (int n = 0; n < 2; ++n) _Pragma("unroll") for (int k = 0; k < 2; ++k) \
        acc[ai][bj][m][n] = __builtin_amdgcn_mfma_f32_16x16x32_bf16(Bt[n][k], At[m][k], acc[ai][bj][m][n], 0, 0, 0); __builtin_amdgcn_s_setprio(0); } while (0)
#define PG8_WAIT_V(n) asm volatile("s_waitcnt vmcnt(" #n ")" ::: "memory")
#define PG8_WAIT_L(n) asm volatile("s_waitcnt lgkmcnt(" #n ")" ::: "memory")
#define PG8_BAR __builtin_amdgcn_s_barrier()
#define PG8_SCHED __builtin_amdgcn_sched_barrier(0)
#define PG8_BPTR(u) ((const char*)g.Bt + (size_t)((u).pm / g.mt_per_group) * g.strideB * 2 + (size_t)(u).pn * tstepB)
    Unit cur, nxt; int ui = 0;
    if (!S.next(0, cur)) return;
    f32x4 acc[2][2][4][2];
#pragma unroll
    for (int a = 0; a < 2; ++a)
#pragma unroll
        for (int b = 0; b < 2; ++b)
#pragma unroll
            for (int m = 0; m < 4; ++m)
#pragma unroll
                for (int n = 0; n < 2; ++n) acc[a][b][m][n] = (f32x4){0.f, 0.f, 0.f, 0.f};
    bf16x8 At[4][2], B0[2][2], B1[2][2];
    const char* cA = (const char*)g.A + (size_t)cur.pm * tstepA; const char* cB = PG8_BPTR(cur);
    PG8_STAGE(PG8_SB(0, 0), cB, voffB); PG8_STAGE(PG8_SB(0, 1), cB + hstepB, voffB); PG8_STAGE(PG8_SA(0, 0), cA, voffA); PG8_STAGE(PG8_SA(0, 1), cA + hstepA, voffA);
    if (wr == 1) PG8_BAR;
    PG8_WAIT_V(2); PG8_BAR;
    PG8_STAGE(PG8_SB(1, 0), cB + kstep, voffB); PG8_STAGE(PG8_SA(1, 0), cA + kstep, voffA); PG8_STAGE(PG8_SB(1, 1), cB + hstepB + kstep, voffB);
    PG8_WAIT_V(6); PG8_BAR;
    for (;;) {
        const bool has_next = S.next(ui + 1, nxt);
        const char* nA = has_next ? (const char*)g.A + (size_t)nxt.pm * tstepA : cA; const char* nB = has_next ? PG8_BPTR(nxt) : cB;
        for (int t = 0; t < nt; t += 2) {
            const bool last = (t == nt - 2);
            const char* a1 = cA + (size_t)(t + 1) * kstep;
            const char* a2 = last ? nA : cA + (size_t)(t + 2) * kstep; const char* b2 = last ? nB : cB + (size_t)(t + 2) * kstep;
            const char* a3 = a2 + kstep; const char* b3 = b2 + kstep;
            PG8_LDB(B0, 0, 0); PG8_LDB(B1, 0, 1); PG8_SCHED; PG8_LDA(At, 0, 0); PG8_STAGE(PG8_SA(1, 1), a1 + hstepA, voffA);
            PG8_WAIT_V(8); PG8_WAIT_L(0); PG8_BAR; PG8_MMA(0, 0, At, B0); PG8_MMA(0, 1, At, B1); PG8_BAR; PG8_SCHED;
            PG8_LDA(At, 0, 1); PG8_STAGE(PG8_SB(0, 0), b2, voffB); PG8_STAGE(PG8_SB(0, 1), b2 + hstepB, voffB); PG8_STAGE(PG8_SA(0, 0), a2, voffA);
            PG8_WAIT_V(8); PG8_WAIT_L(0); PG8_BAR; PG8_MMA(1, 0, At, B0); PG8_MMA(1, 1, At, B1); PG8_BAR; PG8_SCHED;
            PG8_LDB(B0, 1, 0); PG8_LDB(B1, 1, 1); PG8_SCHED; PG8_LDA(At, 1, 0); PG8_STAGE(PG8_SA(0, 1), a2 + hstepA, voffA);
            PG8_WAIT_V(8); PG8_WAIT_L(0); PG8_BAR; PG8_MMA(0, 0, At, B0); PG8_MMA(0, 1, At, B1); PG8_BAR; PG8_SCHED;
            PG8_LDA(At, 1, 1); PG8_STAGE(PG8_SB(1, 0), b3, voffB); PG8_STAGE(PG8_SB(1, 1), b3 + hstepB, voffB); PG8_STAGE(PG8_SA(1, 0), a3, voffA);
            PG8_WAIT_V(8); PG8_WAIT_L(0); PG8_BAR; PG8_MMA(1, 0, At, B0); PG8_MMA(1, 1, At, B1); PG8_BAR; PG8_SCHED;
        }
        if (wr == 0) PG8_BAR;
        { int t2_ = threadIdx.x; asm volatile("" : "+v"(t2_)); const int w2_ = t2_ >> 6, l2_ = t2_ & 63; E(acc, cur, w2_ >> 2, w2_ & 3, l2_ & 15, l2_ >> 4); }
        if (!has_next) break;
#pragma unroll
        for (int a = 0; a < 2; ++a)
#pragma unroll
            for (int b = 0; b < 2; ++b)
#pragma unroll
                for (int m = 0; m < 4; ++m)
#pragma unroll
                    for (int n = 0; n < 2; ++n) acc[a][b][m][n] = (f32x4){0.f, 0.f, 0.f, 0.f};
        cur = nxt; cA = nA; cB = nB; ++ui;
        if (wr == 1) PG8_BAR;
    }
    PG8_WAIT_V(0);
    PG8_BAR;
#undef PG8_SA
#undef PG8_SB
#undef PG8_STAGE
#undef PG8_LDA
#undef PG8_LDB
#undef PG8_MMA
#undef PG8_WAIT_V
#undef PG8_WAIT_L
#undef PG8_BAR
#undef PG8_SCHED
#undef PG8_BPTR
}
typedef f32x4 Acc[2][2][4][2];
DI u32x4 pack8(const f32x4 v0, const f32x4 v1) { u32x4 w; w.x = cvtpk(v0[0], v0[1]); w.y = cvtpk(v0[2], v0[3]); w.z = cvtpk(v1[0], v1[1]); w.w = cvtpk(v1[2], v1[3]); return w; }
struct EpiBf16 {
    static constexpr bool PERM = true; bf16_t* O; int ldc;
    DI void operator()(const Acc& acc, const Unit& u, int wr, int wc, int fr, int fq) const {
        const int row0 = u.pm * BM + wr * 64 + fr, col0 = u.pn * BM + wc * 32 + 8 * fq;
#pragma unroll
        for (int ai = 0; ai < 2; ++ai)
#pragma unroll
            for (int m = 0; m < 4; ++m) { bf16_t* rowp = O + (size_t)(row0 + ai * HALF + m * 16) * ldc + col0;
#pragma unroll
                for (int bj = 0; bj < 2; ++bj) *(u32x4*)(rowp + bj * HALF) = pack8(acc[ai][bj][m][0], acc[ai][bj][m][1]); }
    }
};
struct EpiSwiglu {
    static constexpr bool PERM = true; bf16_t* O;
    DI void operator()(const Acc& acc, const Unit& u, int wr, int wc, int fr, int fq) const {
        const int row0 = u.pm * BM + wr * 64 + fr, col0 = u.pn * HALF + wc * 32 + 8 * fq;
#pragma unroll
        for (int ai = 0; ai < 2; ++ai)
#pragma unroll
            for (int m = 0; m < 4; ++m) { f32x4 r0, r1;
#pragma unroll
                for (int j = 0; j < 4; ++j) { const float g0 = acc[ai][0][m][0][j], g1 = acc[ai][0][m][1][j]; r0[j] = g0 * sigm(g0) * acc[ai][1][m][0][j]; r1[j] = g1 * sigm(g1) * acc[ai][1][m][1][j]; }
                *(u32x4*)(O + (size_t)(row0 + ai * HALF + m * 16) * FF + col0) = pack8(r0, r1); }
    }
};
struct EpiF32 {
    static constexpr bool PERM = false; float* O; int ldc;
    DI void operator()(const Acc& acc, const Unit& u, int wr, int wc, int fr, int fq) const {
        const int row0 = u.pm * BM + wr * 64 + fr, col0 = u.pn * BM + wc * 32 + 4 * fq;
#pragma unroll
        for (int ai = 0; ai < 2; ++ai)
#pragma unroll
            for (int m = 0; m < 4; ++m) { float* rowp = O + (size_t)(row0 + ai * HALF + m * 16) * ldc + col0;
#pragma unroll
                for (int bj = 0; bj < 2; ++bj)
#pragma unroll
                    for (int n = 0; n < 2; ++n) *(f32x4*)(rowp + bj * HALF + n * 16) = acc[ai][bj][m][n]; }
    }
};
struct EpiGlu {
    static constexpr bool PERM = true; bf16_t* O;
    DI void operator()(const Acc& acc, const Unit& u, int wr, int wc, int fr, int fq) const {
        const int row0 = u.pm * BM + wr * 64 + fr, col0 = u.pn * HALF + wc * 32 + 8 * fq;
#pragma unroll
        for (int ai = 0; ai < 2; ++ai)
#pragma unroll
            for (int m = 0; m < 4; ++m) { f32x4 r0, r1;
#pragma unroll
                for (int j = 0; j < 4; ++j) { r0[j] = acc[ai][0][m][0][j] * sigm(acc[ai][1][m][0][j]); r1[j] = acc[ai][0][m][1][j] * sigm(acc[ai][1][m][1][j]); }
                *(u32x4*)(O + (size_t)(row0 + ai * HALF + m * 16) * D + col0) = pack8(r0, r1); }
    }
};
struct EpiS5In {
    static constexpr bool PERM = true; bf16_t* XE; float* UC;
    DI void operator()(const Acc& acc, const Unit& u, int wr, int wc, int fr, int fq) const {
        const int row0 = u.pm * BM + wr * 64 + fr, col0 = u.pn * BM + wc * 32 + 8 * fq;
#pragma unroll
        for (int ai = 0; ai < 2; ++ai)
#pragma unroll
            for (int m = 0; m < 4; ++m) { const int row = row0 + ai * HALF + m * 16;
#pragma unroll
                for (int bj = 0; bj < 2; ++bj) { const int c8 = col0 + bj * HALF;
                    if (row < TL) { const int b = row >> 13, s = row & 8191, gi = c8 >> 4;
                        *(u32x4*)(XE + ((size_t)(gi * 1024 + b * 128 + (s >> 6)) * XE_K + (s & 63) * 16 + (c8 & 15))) = pack8(acc[ai][bj][m][0], acc[ai][bj][m][1]); }
                    else { float* p = UC + (size_t)(row - TL) * D + c8; *(f32x4*)p = acc[ai][bj][m][0]; *(f32x4*)(p + 4) = acc[ai][bj][m][1]; } } }
    }
};
struct EpiS5Out {
    static constexpr bool PERM = true; bf16_t* YG;
    DI void operator()(const Acc& acc, const Unit& u, int wr, int wc, int fr, int fq) const {
        const int row0 = u.pm * BM + wr * 64 + fr, col0 = u.pn * BM + wc * 32 + 8 * fq;
#pragma unroll
        for (int ai = 0; ai < 2; ++ai)
#pragma unroll
            for (int m = 0; m < 4; ++m) { const int rf = row0 + ai * HALF + m * 16, gi = rf >> 10, r = rf & 1023, b = r >> 7, c = r & 127;
#pragma unroll
                for (int bj = 0; bj < 2; ++bj) { const int n8 = col0 + bj * HALF, tp = n8 >> 4, ho = n8 & 15; f32x4 r0, r1;
#pragma unroll
                    for (int j = 0; j < 4; ++j) { const float y0 = acc[ai][bj][m][0][j], y1 = acc[ai][bj][m][1][j];
                        r0[j] = y0 * sigm(1.5957691216f * (y0 + 0.044715f * y0 * y0 * y0)); r1[j] = y1 * sigm(1.5957691216f * (y1 + 0.044715f * y1 * y1 * y1)); }
                    *(u32x4*)(YG + (size_t)(b * SEQ + c * 64 + tp) * D + gi * 16 + ho) = pack8(r0, r1); } }
    }
};
}

DI int crow(int i, int h) { return (i & 3) + 8 * (i >> 2) + 4 * h; }
DI bf16x8 rope_pair_lo(const bf16x8 x1, const bf16x8 x2, const float* cs, const float* sn, bf16x8& out2) {
    bf16x8 o1;
#pragma unroll
    for (int j = 0; j < 8; ++j) { const float a = bf2f((unsigned short)x1[j]), b = bf2f((unsigned short)x2[j]), c = cs[j], s = sn[j];
        o1[j] = (short)f2bf(a * c - b * s); out2[j] = (short)f2bf(a * s + b * c); }
    return o1;
}
template <int DQK>
DI void attn_unit(LAS unsigned char* lds, const bf16_t* Qrow0, int qpitch,
                  const bf16_t* KA_ctx, const bf16_t* KA_lat, int pA, const bf16_t* KB_ctx, const bf16_t* KB_lat, int pB,
                  const bf16_t* V_ctx, const bf16_t* V_lat, int pV, bf16_t* Orow0, int opitch,
                  int t_lo2, int t_hi2, bool band, int q0, float sc, bool has_sink, float sink_l2, int rope, const float* ropeT) {
    constexpr int NCH = DQK / 8, KP = DQK + 8, VP = 96, ND = DQK / 16;
    constexpr int KBUF = 64 * KP * 2, VBUF = 64 * VP * 2, VOFF = 2 * KBUF;
    int tid_ = threadIdx.x; asm volatile("" : "+v"(tid_));
    const int tid = tid_, lane = tid & 63, wid = __builtin_amdgcn_readfirstlane(tid >> 6), r = lane & 31, h = lane >> 5;
    bf16x8 qf[ND];
    { const bf16_t* qrow = Qrow0 + (size_t)(wid * 32 + r) * qpitch;
#pragma unroll
      for (int d0 = 0; d0 < ND; ++d0) qf[d0] = *(const bf16x8*)(qrow + 16 * d0 + 8 * h);
      if (rope) { const int pos = q0 + wid * 32 + r, rr = pos >> 6, cc = pos & 63;
        if (DQK == 96) { const float* cA = ropeT; const float* sA = ropeT + 1024; const int p = h ? cc : rr;
            bf16x8 o2; const bf16x8 o1 = rope_pair_lo(qf[ND - 2], qf[ND - 1], cA + p * 8, sA + p * 8, o2); qf[ND - 2] = o1; qf[ND - 1] = o2; }
        else { const float* cB = ropeT + 2048; const float* sB = ropeT + 4096;
            bf16x8 o2; bf16x8 o1 = rope_pair_lo(qf[0], qf[2], cB + rr * 16 + 8 * h, sB + rr * 16 + 8 * h, o2); qf[0] = o1; qf[2] = o2;
            o1 = rope_pair_lo(qf[1], qf[3], cB + cc * 16 + 8 * h, sB + cc * 16 + 8 * h, o2); qf[1] = o1; qf[3] = o2; } }
#pragma unroll
      for (int d0 = 0; d0 < ND; ++d0) { u32x4 w;
#pragma unroll
        for (int j = 0; j < 4; ++j) w[j] = cvtpk(bf2f((unsigned short)qf[d0][2 * j]) * sc, bf2f((unsigned short)qf[d0][2 * j + 1]) * sc);
        qf[d0] = __builtin_bit_cast(bf16x8, w); } }
    const int ntl = 4 + (t_hi2 - t_lo2);
    const bool k1v = (tid + 512) < 64 * NCH;
    const int grp = wid >> 2;
    u32x4 kr0, kr1 = (u32x4){0u, 0u, 0u, 0u}, vr;
#define AT_LOADK(t) do { const bool ic_ = (t) < 4; const int rb_ = ic_ ? (t) * 64 : (t_lo2 + (t) - 4) * 64; \
        { const int ch_ = tid, row_ = ch_ / NCH, c_ = ch_ % NCH; const bf16_t* s_ = (DQK == 64 || c_ < 8) ? (ic_ ? KA_ctx : KA_lat) + (size_t)(rb_ + row_) * pA + c_ * 8 : (ic_ ? KB_ctx : KB_lat) + (size_t)(rb_ + row_) * pB + (c_ - 8) * 8; kr0 = *(const u32x4*)s_; } \
        if (k1v) { const int ch_ = tid + 512, row_ = ch_ / NCH, c_ = ch_ % NCH; const bf16_t* s_ = (DQK == 64 || c_ < 8) ? (ic_ ? KA_ctx : KA_lat) + (size_t)(rb_ + row_) * pA + c_ * 8 : (ic_ ? KB_ctx : KB_lat) + (size_t)(rb_ + row_) * pB + (c_ - 8) * 8; kr1 = *(const u32x4*)s_; } } while (0)
#define AT_LOADV(t) do { const bool ic_ = (t) < 4; const int rb_ = ic_ ? (t) * 64 : (t_lo2 + (t) - 4) * 64; \
        { const int row_ = tid >> 3, c_ = tid & 7; vr = *(const u32x4*)((ic_ ? V_ctx : V_lat) + (size_t)(rb_ + row_) * pV + c_ * 8); } } while (0)
#define AT_STOREK(buf) do { { const int ch_ = tid, row_ = ch_ / NCH, c_ = ch_ % NCH; *(LAS u32x4*)(lds + (buf) * KBUF + (row_ * KP + c_ * 8) * 2) = kr0; } \
        if (k1v) { const int ch_ = tid + 512, row_ = ch_ / NCH, c_ = ch_ % NCH; *(LAS u32x4*)(lds + (buf) * KBUF + (row_ * KP + c_ * 8) * 2) = kr1; } } while (0)
#define AT_STOREV(buf) do { const int row_ = tid >> 3, c_ = tid & 7; *(LAS u32x4*)(lds + VOFF + (buf) * VBUF + (row_ * VP + c_ * 8) * 2) = vr; } while (0)
    float m_run = has_sink ? sink_l2 : 0.f, l_run = (has_sink && h == 0) ? 1.f : 0.f;
    bool started = false;
    f32x16 o0, o1, p0, p1, negm;
#pragma unroll
    for (int i = 0; i < 16; ++i) { o0[i] = 0.f; o1[i] = 0.f; p0[i] = 0.f; p1[i] = 0.f; negm[i] = -m_run; }
    bf16x8 pa[2][2];
#pragma unroll
    for (int a = 0; a < 2; ++a)
#pragma unroll
        for (int b = 0; b < 2; ++b) pa[a][b] = (bf16x8){0, 0, 0, 0, 0, 0, 0, 0};
    const int qw = q0 + wid * 32;
    const int vlane = (((lane & 15) >> 2) * VP + 16 * ((lane >> 4) & 1)) * 2 + 8 * (lane & 3) + (4 * h) * VP * 2;
    AT_LOADK(0); AT_STOREK(0);
    if (1 < ntl) AT_LOADK(1);
    AT_LOADV(0);
    __syncthreads();
    if (grp == 1) __syncthreads();
    bool act = false, act_prev = false; int kt0 = 0;
    for (int t = 0; t <= ntl; ++t) {
        if (t + 1 < ntl) AT_STOREK((t + 1) & 1);
        if (t < ntl) AT_STOREV(t & 1);
        if (t + 2 < ntl) AT_LOADK(t + 2);
        if (t + 1 < ntl) AT_LOADV(t + 1);
        if (t >= 1 && act_prev) {
            const LAS unsigned char* Vb = lds + VOFF + ((t - 1) & 1) * VBUF;
#pragma unroll
            for (int kb = 0; kb < 2; ++kb)
#pragma unroll
                for (int s = 0; s < 2; ++s) {
                    const LAS unsigned char* vb = Vb + vlane + (kb * 32 + 16 * s) * VP * 2;
#pragma unroll
                    for (int db = 0; db < 2; ++db) {
                        const s16x4 lo = __builtin_bit_cast(s16x4, __builtin_amdgcn_ds_read_tr16_b64_v4i16((LAS s16x4*)(vb + db * 64)));
                        const s16x4 hi = __builtin_bit_cast(s16x4, __builtin_amdgcn_ds_read_tr16_b64_v4i16((LAS s16x4*)(vb + db * 64 + 8 * VP * 2)));
                        const bf16x8 vf = __builtin_shufflevector(lo, hi, 0, 1, 2, 3, 4, 5, 6, 7);
                        if (db == 0) o0 = __builtin_amdgcn_mfma_f32_32x32x16_bf16(vf, pa[kb][s], o0, 0, 0, 0);
                        else o1 = __builtin_amdgcn_mfma_f32_32x32x16_bf16(vf, pa[kb][s], o1, 0, 0, 0);
                    }
                }
        }
        act = false;
        if (t < ntl) {
            act = true;
            if (band && t >= 4) { kt0 = (t_lo2 + t - 4) * 64; act = (kt0 + 63 >= qw - 128) && (kt0 <= qw + 31 + 128); }
            if (act) {
                const LAS unsigned char* Kb = lds + (t & 1) * KBUF;
#pragma unroll
                for (int d0 = 0; d0 < ND; ++d0) {
                    const bf16x8 k0 = *(const LAS bf16x8*)(Kb + (r * KP + 16 * d0 + 8 * h) * 2);
                    const bf16x8 k1 = *(const LAS bf16x8*)(Kb + ((32 + r) * KP + 16 * d0 + 8 * h) * 2);
                    if (d0 == 0) { p0 = __builtin_amdgcn_mfma_f32_32x32x16_bf16(k0, qf[d0], negm, 0, 0, 0); p1 = __builtin_amdgcn_mfma_f32_32x32x16_bf16(k1, qf[d0], negm, 0, 0, 0); }
                    else { p0 = __builtin_amdgcn_mfma_f32_32x32x16_bf16(k0, qf[d0], p0, 0, 0, 0); p1 = __builtin_amdgcn_mfma_f32_32x32x16_bf16(k1, qf[d0], p1, 0, 0, 0); }
                }
            }
        }
        __syncthreads();
        if (act) {
            if (band && t >= 4) { const int qpos = qw + r;
#pragma unroll
                for (int i = 0; i < 16; ++i) { const int kp = kt0 + crow(i, h); int d = qpos - kp; d = d < 0 ? -d : d; if (d > 128) p0[i] = -1e30f; int d2 = qpos - kp - 32; d2 = d2 < 0 ? -d2 : d2; if (d2 > 128) p1[i] = -1e30f; } }
            f32x16 e0, e1; unsigned um = 0u;
#pragma unroll
            for (int i = 0; i < 16; ++i) { e0[i] = __builtin_amdgcn_exp2f(p0[i]); e1[i] = __builtin_amdgcn_exp2f(p1[i]); const unsigned a = __float_as_uint(e0[i]), b = __float_as_uint(e1[i]); um = um > a ? um : a; um = um > b ? um : b; }
            { auto rr = __builtin_amdgcn_permlane32_swap(um, um, false, false); um = rr[0] > rr[1] ? rr[0] : rr[1]; }
            if (!started || __any(um > 0x43800000u)) {
                float mx = fmaxf(p0[0], p1[0]);
#pragma unroll
                for (int i = 1; i < 16; ++i) mx = fmaxf(mx, fmaxf(p0[i], p1[i]));
                { auto rr = __builtin_amdgcn_permlane32_swap(__float_as_uint(mx), __float_as_uint(mx), false, false); mx = fmaxf(__uint_as_float(rr[0]), __uint_as_float(rr[1])); }
                float alpha = 1.f;
                if (started || has_sink) { mx = fmaxf(mx, 0.f); alpha = __builtin_amdgcn_exp2f(-mx); }
                m_run += mx; l_run *= alpha;
#pragma unroll
                for (int i = 0; i < 16; ++i) { o0[i] *= alpha; o1[i] *= alpha; e0[i] = __builtin_amdgcn_exp2f(p0[i] - mx); e1[i] = __builtin_amdgcn_exp2f(p1[i] - mx); negm[i] = -m_run; }
                started = true;
            }
            float sum = 0.f;
#pragma unroll
            for (int i = 0; i < 16; ++i) { sum += e0[i] + e1[i]; p0[i] = e0[i]; p1[i] = e1[i]; }
            l_run += sum;
#pragma unroll
            for (int s = 0; s < 2; ++s) { u32x4 w; w.x = cvtpk(p0[8 * s], p0[8 * s + 1]); w.y = cvtpk(p0[8 * s + 2], p0[8 * s + 3]); w.z = cvtpk(p0[8 * s + 4], p0[8 * s + 5]); w.w = cvtpk(p0[8 * s + 6], p0[8 * s + 7]); pa[0][s] = __builtin_bit_cast(bf16x8, w);
                u32x4 w2; w2.x = cvtpk(p1[8 * s], p1[8 * s + 1]); w2.y = cvtpk(p1[8 * s + 2], p1[8 * s + 3]); w2.z = cvtpk(p1[8 * s + 4], p1[8 * s + 5]); w2.w = cvtpk(p1[8 * s + 6], p1[8 * s + 7]); pa[1][s] = __builtin_bit_cast(bf16x8, w2); }
        }
        act_prev = act;
        __syncthreads();
    }
    if (grp == 0) __syncthreads();
#undef AT_LOADK
#undef AT_LOADV
#undef AT_STOREK
#undef AT_STOREV
    const float lt = l_run + __shfl_xor(l_run, 32), inv = 1.f / lt;
    bf16_t* orow = Orow0 + (size_t)(wid * 32 + r) * opitch;
#pragma unroll
    for (int g = 0; g < 4; ++g) {
        u32x2 w; w.x = cvtpk(o0[4 * g] * inv, o0[4 * g + 1] * inv); w.y = cvtpk(o0[4 * g + 2] * inv, o0[4 * g + 3] * inv); *(u32x2*)(orow + 8 * g + 4 * h) = w;
        u32x2 w2; w2.x = cvtpk(o1[4 * g] * inv, o1[4 * g + 1] * inv); w2.y = cvtpk(o1[4 * g + 2] * inv, o1[4 * g + 3] * inv); *(u32x2*)(orow + 32 + 8 * g + 4 * h) = w2;
    }
}


#define XB_TMO      128
#define XB_XCNT(j)  (256  + 64 * (j))
#define XB_XSUB(j)  (1280 + 64 * (j))
#define XB_XGEN(j)  (2304 + 64 * (j))
#define XB_TOP      3328
#define XB_TOPGEN   3392
#define XCD_BAR_WORDS 3456
#define XB_SPIN_CAP (1u << 18)
DI unsigned xb_ld(unsigned* p)              { return __hip_atomic_load(p, __ATOMIC_RELAXED, __HIP_MEMORY_SCOPE_AGENT); }
DI unsigned xb_add(unsigned* p, unsigned v) { return __hip_atomic_fetch_add(p, v, __ATOMIC_RELAXED, __HIP_MEMORY_SCOPE_AGENT); }
DI unsigned xb_xcc_id() { return (unsigned)__builtin_amdgcn_s_getreg((3 << 11) | 20) & 0xFu; }
#define XB_SPIN(cond, bar) do { unsigned _sp = 0; while (cond) { __builtin_amdgcn_s_sleep(1); \
    if ((++_sp & 255u) == 0u) { if (xb_ld(&(bar)[XB_TMO])) break; if (_sp > XB_SPIN_CAP) { atomicAdd(&(bar)[XB_TMO], 1u); break; } } } } while (0)
struct XcdBarrier { unsigned* bar; unsigned x; volatile LAS unsigned* st; };
DI void xcd_barrier_complete(unsigned* bar, unsigned x, unsigned& nloc, unsigned& nx) {
    const unsigned G = gridDim.x * gridDim.y * gridDim.z;
    unsigned sum, cnt, mine, sp = 0u;
    for (;;) {
        sum = 0u; cnt = 0u; mine = 0u;
#pragma unroll
        for (unsigned j = 0; j < 16; ++j) { const unsigned c = xb_ld(&bar[XB_XCNT(j)]); sum += c; cnt += (c > 0u) ? 1u : 0u; mine = (j == x) ? c : mine; }
        if (sum == G) break;
        __builtin_amdgcn_s_sleep(1);
        if ((++sp & 255u) == 0u) { if (xb_ld(&bar[XB_TMO])) break; if (sp > XB_SPIN_CAP) { atomicAdd(&bar[XB_TMO], 1u); break; } }
    }
    nloc = mine > 0u ? mine : 1u; nx = cnt > 0u ? cnt : 1u;
}
DI void xcd_barrier(const XcdBarrier& b) {
    asm volatile("s_waitcnt vmcnt(0)" ::: "memory");
    __syncthreads();
    if (threadIdx.x == 0) {
        unsigned* bar = b.bar;
        __builtin_amdgcn_s_waitcnt(0);
        unsigned nloc = b.st[0], nx = b.st[1];
        if (nloc == 0u) { xcd_barrier_complete(bar, b.x, nloc, nx); b.st[0] = nloc; b.st[1] = nx; }
        const unsigned old = xb_add(&bar[XB_XSUB(b.x)], 1u);
        const unsigned gen = old / nloc;
        if (old + 1u == (gen + 1u) * nloc) {
            __builtin_amdgcn_fence(__ATOMIC_RELEASE, "agent");
            asm volatile("s_waitcnt vmcnt(0)" ::: "memory");
            const unsigned og = xb_add(&bar[XB_TOP], 1u);
            const unsigned tg = og / nx;
            if (og + 1u == (tg + 1u) * nx) xb_add(&bar[XB_TOPGEN], 1u);
            else XB_SPIN(xb_ld(&bar[XB_TOPGEN]) == tg, bar);
            __builtin_amdgcn_fence(__ATOMIC_ACQUIRE, "agent");
            xb_add(&bar[XB_XGEN(b.x)], 1u);
            asm volatile("s_waitcnt vmcnt(0)" ::: "memory");
        } else {
            XB_SPIN(xb_ld(&bar[XB_XGEN(b.x)]) == gen, bar);
            __builtin_amdgcn_fence(__ATOMIC_ACQUIRE, "agent");
            asm volatile("s_waitcnt vmcnt(0)" ::: "memory");
        }
    }
    __syncthreads();
}
constexpr int XB_LDS_OFF = 131072 + 64;

struct Args { const float* in[27]; float* out; unsigned char* ws; };
enum { I_X = 0, I_C, I_CTX, I_CCTX, I_MODW, I_MODB, I_NPRE, I_NPOST, I_W13, I_W2, I_AWIN, I_QNORM, I_WUQ, I_KVNORM, I_WUKV, I_SINK, I_AWOUT, I_S5WIN, I_LRE, I_LIM, I_BRE, I_BIM, I_CRE, I_CIM, I_LSTEP, I_S5D, I_WGLU };

DI void transpose_item(const float* W, int N, bf16_t* WT, int ldk, int koff, int drow0, LAS float* scr, int k0, int n0, int lane) {
#pragma unroll 8
    for (int i = 0; i < 32; ++i) { const int kk = 2 * i + (lane >> 5); scr[kk * 33 + (lane & 31)] = W[(size_t)(k0 + kk) * N + n0 + (lane & 31)]; }
    asm volatile("s_waitcnt lgkmcnt(0)" ::: "memory");
    const int c = lane & 7;
#pragma unroll
    for (int j = 0; j < 4; ++j) { const int n = (lane >> 3) + 8 * j; const LAS float* s = scr + (8 * c) * 33 + n;
        u32x4 o; o.x = cvtpk(s[0 * 33], s[1 * 33]); o.y = cvtpk(s[2 * 33], s[3 * 33]); o.z = cvtpk(s[4 * 33], s[5 * 33]); o.w = cvtpk(s[6 * 33], s[7 * 33]);
        *(u32x4*)(WT + (size_t)(drow0 + n) * ldk + koff + k0 + 8 * c) = o; }
    asm volatile("s_waitcnt lgkmcnt(0)" ::: "memory");
}
DI int pairmap(int n0, int split) { const int jj = n0 < split ? n0 : n0 - split; return (jj >> 7) * 256 + (n0 < split ? 0 : 128) + (jj & 127); }

struct RowOp {
    const void* hin_lat; const void* hin_ctx; bool hin_bf16; void* hout_lat; void* hout_ctx; bool hout_bf16;
    const bf16_t* Y; const float* g_post; const float* modg; int gate_idx; float coef;
    const float* g_pre; const float* modp; int shift_idx, scale_idx; bf16_t* A; int nrows;
};
DI void unpack8(const u32x4 w, float* v) {
#pragma unroll
    for (int e = 0; e < 4; ++e) { v[2 * e] = __builtin_bit_cast(float, w[e] << 16); v[2 * e + 1] = __builtin_bit_cast(float, w[e] & 0xffff0000u); }
}
DI void ld16(const float* v, int lane, float* d) {
    const f32x4* p = (const f32x4*)v;
#pragma unroll
    for (int j = 0; j < 2; ++j)
#pragma unroll
        for (int q = 0; q < 2; ++q) { const f32x4 x = p[2 * lane + q + 128 * j];
#pragma unroll
            for (int e = 0; e < 4; ++e) d[8 * j + 4 * q + e] = x[e]; }
}
DI void row_phase(const RowOp& o, int gw, int ngw, int lane) {
    const int chunk = (o.nrows + ngw - 1) / ngw, rbeg = gw * chunk, rend = (rbeg + chunk) < o.nrows ? (rbeg + chunk) : o.nrows;
    float gpo[16], gpr[16], gat[16], shf[16], scl[16]; int cur = -1;
#pragma unroll
    for (int e = 0; e < 16; ++e) { gpo[e] = 0.f; gpr[e] = 0.f; gat[e] = 0.f; shf[e] = 0.f; scl[e] = 0.f; }
    if (o.Y) ld16(o.g_post, lane, gpo);
    if (o.g_pre) ld16(o.g_pre, lane, gpr);
    for (int row0 = rbeg; row0 < rend; row0 += 4) {
        float hv[4][16], yv[4][16]; bool ok[4]; int rows[4];
#pragma unroll
        for (int u = 0; u < 4; ++u) { const int row = row0 + u; rows[u] = row; ok[u] = row < rend;
            if (ok[u]) { const size_t roff = row < TL ? (size_t)row * D : (size_t)(row - TL) * D;
                if (o.hin_bf16) { const u32x4* hp = (const u32x4*)((const bf16_t*)(row < TL ? o.hin_lat : o.hin_ctx) + roff);
#pragma unroll
                    for (int j = 0; j < 2; ++j) unpack8(hp[lane + 64 * j], &hv[u][8 * j]); }
                else { const f32x4* hp = (const f32x4*)((const float*)(row < TL ? o.hin_lat : o.hin_ctx) + roff);
#pragma unroll
                    for (int j = 0; j < 2; ++j) { const f32x4 a = hp[2 * lane + 128 * j], b = hp[2 * lane + 1 + 128 * j];
#pragma unroll
                        for (int e = 0; e < 4; ++e) { hv[u][8 * j + e] = a[e]; hv[u][8 * j + 4 + e] = b[e]; } } }
                if (o.Y) { const u32x4* yp = (const u32x4*)(o.Y + (size_t)row * D);
#pragma unroll
                    for (int j = 0; j < 2; ++j) unpack8(yp[lane + 64 * j], &yv[u][8 * j]); } } }
#pragma unroll
        for (int u = 0; u < 4; ++u) if (ok[u]) { const int row = rows[u]; const int mrow = row < TL ? (row >> 13) : 8; const size_t roff = row < TL ? (size_t)row * D : (size_t)(row - TL) * D;
            if (mrow != cur) { cur = mrow;
                if (o.Y) { ld16(o.modg + (size_t)mrow * 9216 + o.gate_idx * D, lane, gat);
#pragma unroll
                    for (int e = 0; e < 16; ++e) gat[e] *= o.coef; }
                if (o.g_pre) { ld16(o.modp + (size_t)mrow * 9216 + o.shift_idx * D, lane, shf); ld16(o.modp + (size_t)mrow * 9216 + o.scale_idx * D, lane, scl);
#pragma unroll
                    for (int e = 0; e < 16; ++e) scl[e] += 1.0f; } }
            if (o.Y) {
                float ss = 0.f;
#pragma unroll
                for (int e = 0; e < 16; ++e) ss += yv[u][e] * yv[u][e];
                const float rstd = 1.0f / sqrtf(wave_sum(ss) * (1.f / D) + EPSV);
#pragma unroll
                for (int e = 0; e < 16; ++e) hv[u][e] += gat[e] * (yv[u][e] * rstd * gpo[e]);
                if (o.hout_bf16) { u32x4* op = (u32x4*)((bf16_t*)(row < TL ? o.hout_lat : o.hout_ctx) + roff);
#pragma unroll
                    for (int j = 0; j < 2; ++j) { u32x4 w;
#pragma unroll
                        for (int e = 0; e < 4; ++e) w[e] = cvtpk(hv[u][8 * j + 2 * e], hv[u][8 * j + 2 * e + 1]);
                        op[lane + 64 * j] = w; unpack8(w, &hv[u][8 * j]); } }
                else { f32x4* op = (f32x4*)((float*)(row < TL ? o.hout_lat : o.hout_ctx) + roff);
#pragma unroll
                    for (int j = 0; j < 2; ++j) { op[2 * lane + 128 * j] = (f32x4){hv[u][8 * j], hv[u][8 * j + 1], hv[u][8 * j + 2], hv[u][8 * j + 3]}; op[2 * lane + 1 + 128 * j] = (f32x4){hv[u][8 * j + 4], hv[u][8 * j + 5], hv[u][8 * j + 6], hv[u][8 * j + 7]}; } }
            }
            if (o.g_pre) {
                float ss = 0.f;
#pragma unroll
                for (int e = 0; e < 16; ++e) ss += hv[u][e] * hv[u][e];
                const float rstd = 1.0f / sqrtf(wave_sum(ss) * (1.f / D) + EPSV);
                u32x4* ap = (u32x4*)(o.A + (size_t)row * D);
#pragma unroll
                for (int j = 0; j < 2; ++j) { u32x4 w;
#pragma unroll
                    for (int e = 0; e < 4; ++e) w[e] = cvtpk((hv[u][8 * j + 2 * e] * rstd * gpr[8 * j + 2 * e]) * scl[8 * j + 2 * e] + shf[8 * j + 2 * e], (hv[u][8 * j + 2 * e + 1] * rstd * gpr[8 * j + 2 * e + 1]) * scl[8 * j + 2 * e + 1] + shf[8 * j + 2 * e + 1]);
                    ap[lane + 64 * j] = w; }
            }
        }
    }
}

#define KSETUP \
    const int G = gridDim.x, bx = blockIdx.x; \
    const int ngw = G * 8, ngt = G * 512; \
    const int vcu = (G % 8 == 0) ? (bx % 8) * (G / 8) + bx / 8 : bx; \
    GAS unsigned char* wsg_ = (GAS unsigned char*)args.ws; asm volatile("" : "+s"(wsg_)); unsigned char* ws = (unsigned char*)wsg_; \
    float* MOD = (float*)(ws + WS_MOD); float* ROPE = (float*)(ws + WS_ROPE); \
    float* ABAR = (float*)(ws + WS_ABAR); float* BBAR = (float*)(ws + WS_BBAR); float* POW = (float*)(ws + WS_POW); float* KTAB = (float*)(ws + WS_KTAB); float* SCTX = (float*)(ws + WS_SCTX); \
    bf16_t* W13T = (bf16_t*)(ws + WS_W13T); bf16_t* W2T = (bf16_t*)(ws + WS_W2T); bf16_t* WINT = (bf16_t*)(ws + WS_WINT); bf16_t* WUT = (bf16_t*)(ws + WS_WUT); \
    bf16_t* WOUTT = (bf16_t*)(ws + WS_WOUTT); bf16_t* S5INT = (bf16_t*)(ws + WS_S5INT); bf16_t* GLUT = (bf16_t*)(ws + WS_GLUT); \
    bf16_t* HCTX = (bf16_t*)(ws + WS_HCTX); bf16_t* Ab = (bf16_t*)(ws + WS_A); bf16_t* Yb = (bf16_t*)(ws + WS_Y); bf16_t* HB = (bf16_t*)(ws + WS_HB); \
    bf16_t* Ub = (bf16_t*)(ws + WS_U); bf16_t* PROJ = (bf16_t*)(ws + WS_PROJ); bf16_t* CN = (bf16_t*)(ws + WS_CN); bf16_t* QKV = (bf16_t*)(ws + WS_QKV); \
    bf16_t* XE = (bf16_t*)(ws + WS_XE); float* UC = (float*)(ws + WS_UC); float* Eb = (float*)(ws + WS_E); bf16_t* BMm = (bf16_t*)(ws + WS_BM); bf16_t* BSm = (bf16_t*)(ws + WS_BS); \
    float* OUT = gl(args.out); \
    const float* MOD0 = MOD; const float* MOD1 = MOD + 9 * 9216; (void)MOD0; (void)MOD1;

#define IN(i) gl(args.in[i])
#define GSYNC() do { for (int rs_ = 0; rs_ < PROBE_SYNC; ++rs_) { GAS unsigned char* wb_ = (GAS unsigned char*)args.ws; asm volatile("" : "+s"(wb_)); XcdBarrier xb_; xb_.bar = (unsigned*)(unsigned char*)wb_; xb_.x = xb_xcc_id(); xb_.st = (volatile LAS unsigned*)(lds + XB_LDS_OFF); xcd_barrier(xb_); } } while (0)
#define TIDS int tid = threadIdx.x; asm volatile("" : "+v"(tid)); const int lane = tid & 63, wave = __builtin_amdgcn_readfirstlane(tid >> 6); const int gw = bx * 8 + wave, gt = bx * 512 + tid, gwx = vcu * 8 + wave; (void)lane; (void)gw; (void)gt; (void)gwx;

DI void prologue_phase(const Args& args, LAS unsigned char* lds) {
    KSETUP
    TIDS
    {
        LAS float* sS = (LAS float*)lds;
        LAS float* sR = (LAS float*)(lds + 36864);
        for (int i = tid; i < 9 * 1024; i += 512) { const int r = i >> 10, k = i & 1023; const float c = r < 8 ? IN(I_C)[r * 1024 + k] : IN(I_CCTX)[k]; sS[i] = c * sigm(c); }
        __syncthreads();
        for (int u = bx; u < 288; u += G) {
            const int l = u / 144, n = (u % 144) * 64 + lane; const float* W = IN(I_MODW) + (size_t)l * 1024 * 9216 + n;
            float acc[9];
#pragma unroll
            for (int r = 0; r < 9; ++r) acc[r] = 0.f;
#pragma unroll 4
            for (int k = wave * 128; k < wave * 128 + 128; ++k) { const float w = W[(size_t)k * 9216];
#pragma unroll
                for (int r = 0; r < 9; ++r) acc[r] += sS[r * 1024 + k] * w; }
#pragma unroll
            for (int r = 0; r < 9; ++r) sR[(wave * 9 + r) * 64 + lane] = acc[r];
            __syncthreads();
            for (int i = tid; i < 9 * 64; i += 512) { const int r = i >> 6, c = i & 63; float s = 0.f;
#pragma unroll
                for (int w = 0; w < 8; ++w) s += sR[(w * 9 + r) * 64 + c];
                const int nn = (u % 144) * 64 + c; MOD[((size_t)l * 9 + r) * 9216 + nn] = s + IN(I_MODB)[l * 9216 + nn]; }
            __syncthreads();
        }
        LAS float* scr = (LAS float*)(lds + wave * 16384);
        constexpr int I13 = 16 * 176, I2 = 44 * 32, IIN = 16 * 37, IUQ = 4 * 24, IUKV = 2 * 32, ISQ = 16 * 32, IGLU = 16 * 64;
        constexpr int NIT = 4 * I13 + 4 * I2 + IIN + IUQ + IUKV + ISQ + ISQ + IGLU;
        for (int it = gw; it < NIT; it += ngw) {
            int r = it;
            if (r < 4 * I13) { const int w = r / I13; r %= I13; const int kb = r / 176, nb = r % 176; transpose_item(IN(I_W13) + (size_t)w * 1024 * 5632, 5632, W13T + (size_t)w * 5632 * 1024, 1024, 0, pairmap(nb * 32, 2816), scr, kb * 64, nb * 32, lane); continue; } r -= 4 * I13;
            if (r < 4 * I2) { const int w = r / I2; r %= I2; const int kb = r / 32, nb = r % 32; transpose_item(IN(I_W2) + (size_t)w * 2816 * 1024, 1024, W2T + (size_t)w * 1024 * 2816, 2816, 0, nb * 32, scr, kb * 64, nb * 32, lane); continue; } r -= 4 * I2;
            if (r < IIN) { const int kb = r / 37, nb = r % 37; transpose_item(IN(I_AWIN), 1184, WINT, 1024, 0, nb * 32, scr, kb * 64, nb * 32, lane); continue; } r -= IIN;
            if (r < IUQ) { const int kb = r / 24, nb = r % 24; transpose_item(IN(I_WUQ), 768, WUT, 384, 0, nb * 32, scr, kb * 64, nb * 32, lane); continue; } r -= IUQ;
            if (r < IUKV) { const int kb = r / 32, nb = r % 32; transpose_item(IN(I_WUKV), 1024, WUT, 384, 256, 768 + nb * 32, scr, kb * 64, nb * 32, lane); continue; } r -= IUKV;
            if (r < ISQ) { const int kb = r / 32, nb = r % 32; transpose_item(IN(I_AWOUT), 1024, WOUTT, 1024, 0, nb * 32, scr, kb * 64, nb * 32, lane); continue; } r -= ISQ;
            if (r < ISQ) { const int kb = r / 32, nb = r % 32; transpose_item(IN(I_S5WIN), 1024, S5INT, 1024, 0, nb * 32, scr, kb * 64, nb * 32, lane); continue; } r -= ISQ;
            { const int kb = r / 64, nb = r % 64; transpose_item(IN(I_WGLU), 2048, GLUT, 1024, 0, pairmap(nb * 32, 1024), scr, kb * 64, nb * 32, lane); }
        }
        const u32x4 z4 = (u32x4){0u, 0u, 0u, 0u};
        for (int i = gt; i < 96 * 128; i += ngt) *(u32x4*)(WINT + (size_t)(1184 + i / 128) * 1024 + (i % 128) * 8) = z4;
        for (int i = gt; i < 768 * 16; i += ngt) *(u32x4*)(WUT + (size_t)(i / 16) * 384 + 256 + (i % 16) * 8) = z4;
        for (int i = gt; i < 1024 * 32; i += ngt) *(u32x4*)(WUT + (size_t)(768 + i / 32) * 384 + (i % 32) * 8) = z4;
        for (int i = gt; i < 128 * 24; i += ngt) { const int p = i / 24, f = i % 24;
            if (f < 8) { const float inv = exp2f(-13.287712379549449f * (2.f * f / 16.f)); float s, c; sincos_rad_d((double)((float)p * inv), s, c); ROPE[p * 8 + f] = c; ROPE[1024 + p * 8 + f] = s; }
            else { const int ff = f - 8; const float inv = exp2f(-13.287712379549449f * (2.f * ff / 32.f)); float s, c; sincos_rad_d((double)((float)p * inv), s, c); ROPE[2048 + p * 16 + ff] = c; ROPE[4096 + p * 16 + ff] = s; } }
        for (int i = gt; i < 2 * 64 * 64; i += ngt) { const int dir = i >> 12, g = (i >> 6) & 63, p = i & 63;
            const float lre = fminf(IN(I_LRE)[i], -1e-4f), lim = IN(I_LIM)[i], dt = __expf(IN(I_LSTEP)[dir * 64 + g]);
            float* pw = POW + (size_t)i * 130;
            for (int d = 0; d <= 64; ++d) { const float mag = __expf(lre * dt * (float)d); float s, c; sincos_rad_d((double)lim * (double)dt * (double)d, s, c); pw[2 * d] = mag * c; pw[2 * d + 1] = mag * s; }
            const float are = pw[2], aim = pw[3]; ABAR[2 * i] = are; ABAR[2 * i + 1] = aim;
            const float den = lre * lre + lim * lim, fre = ((are - 1.f) * lre + aim * lim) / den, fim = (aim * lre - (are - 1.f) * lim) / den;
            for (int hh = 0; hh < 16; ++hh) { const float br = IN(I_BRE)[(size_t)i * 16 + hh], bi = IN(I_BIM)[(size_t)i * 16 + hh]; BBAR[((size_t)i * 16 + hh) * 2] = fre * br - fim * bi; BBAR[((size_t)i * 16 + hh) * 2 + 1] = fre * bi + fim * br; } }
    }

}
#define RUN_GEMM(EPI_T, epi, Aptr, Btptr, M_, N_, K_, lda_, ldb_, mtg_, strB_) do { pg8::Gemm g_{(Aptr), (Btptr), (M_), (N_), (K_), (lda_), (ldb_), (mtg_), (size_t)(strB_)}; pg8::StaticOrder S_; S_.init((M_), (N_), G, bx); \
        pg8::gemm_phase<EPI_T>(lds, g_, S_, (epi)); } while (0)
    constexpr int NOGRP = 1 << 30;


template <int l>
DI void layer_phase(const Args& args, LAS unsigned char* lds, cg::grid_group& grid) {
    KSETUP

        const float* MODL = l == 0 ? MOD0 : MOD1;
        const float* npre = IN(I_NPRE) + l * 3 * D; const float* npost = IN(I_NPOST) + l * 3 * D;
        if (l == 0) {
            TIDS
            for (int rep_ = 0; rep_ < PROBE_MISC; ++rep_) for (int i = gt; i < 64 * 2 * 64 * 16; i += ngt) { const int hh = i & 15, d = (i >> 4) & 63, dir = (i >> 10) & 1, g = i >> 11; const int base = (dir * 64 + g) * 64;
                const float* cr = IN(I_CRE) + ((size_t)(dir * 64 + g) * 16 + hh) * 64; const float* ci = IN(I_CIM) + ((size_t)(dir * 64 + g) * 16 + hh) * 64; float acc[16];
#pragma unroll
                for (int q = 0; q < 16; ++q) acc[q] = 0.f;
#pragma unroll 4
                for (int p = 0; p < 64; ++p) { const float pr = POW[(size_t)(base + p) * 130 + 2 * d], pi = POW[(size_t)(base + p) * 130 + 2 * d + 1]; const float c_r = cr[p], c_i = ci[p];
                    const float al = c_r * pr - c_i * pi, be = c_r * pi + c_i * pr; const f32x4* bb = (const f32x4*)(BBAR + (size_t)(base + p) * 32);
#pragma unroll
                    for (int q = 0; q < 8; ++q) { const f32x4 v = bb[q]; acc[2 * q] += v.x * al - v.y * be; acc[2 * q + 1] += v.z * al - v.w * be; } }
                f32x4* o = (f32x4*)(KTAB + ((((size_t)g * 2 + dir) * 64 + d) * 16 + hh) * 16);
#pragma unroll
                for (int q = 0; q < 4; ++q) o[q] = (f32x4){acc[4 * q], acc[4 * q + 1], acc[4 * q + 2], acc[4 * q + 3]}; }
            RowOp o{IN(I_X), IN(I_CTX), false, nullptr, nullptr, true, nullptr, nullptr, nullptr, 0, 0.f, npre, MODL, 0, 1, Ab, TA};
            row_phase(o, gwx, ngw, lane);
            GSYNC();
        }
        for (int rep_ = 0; rep_ < PROBE_G1; ++rep_) { pg8::EpiSwiglu e{Ub}; RUN_GEMM(pg8::EpiSwiglu, e, Ab, W13T + (size_t)(l * 2) * 5632 * 1024, TA, 5632, 1024, 1024, 1024, NOGRP, 0); }
        GSYNC();
        for (int rep_ = 0; rep_ < PROBE_G2; ++rep_) { pg8::EpiBf16 e{Yb, D}; RUN_GEMM(pg8::EpiBf16, e, Ub, W2T + (size_t)(l * 2) * 1024 * 2816, TA, 1024, 2816, 2816, 2816, NOGRP, 0); }
        GSYNC();
        {
            TIDS
            RowOp o{l == 0 ? (const void*)IN(I_X) : (const void*)HB, l == 0 ? (const void*)IN(I_CTX) : (const void*)HCTX, l != 0, HB, HCTX, true, Yb, npost, MODL, 2, 0.5f, npre + D, MODL, 3, 4, Ab, TA};
            row_phase(o, gwx, ngw, lane);
        }
        GSYNC();
        if (l == 0) {
            { pg8::EpiBf16 e{PROJ, PROJ_N}; RUN_GEMM(pg8::EpiBf16, e, Ab, WINT, TA, PROJ_N, 1024, 1024, 1024, NOGRP, 0); }
            GSYNC();
            { TIDS
            for (int row0 = gw; row0 < TA; row0 += 2 * ngw) {
                u32x2 wq[2]; unsigned wk[2]; float ka[2], kb[2], sa[2], sb[2]; bool ok[2];
#pragma unroll
                for (int u = 0; u < 2; ++u) { const int row = row0 + u * ngw; ok[u] = row < TA; ka[u] = kb[u] = sa[u] = sb[u] = 0.f; wq[u] = (u32x2){0u, 0u}; wk[u] = 0u;
                    if (ok[u]) { const bf16_t* pr = PROJ + (size_t)row * PROJ_N; wq[u] = ((const u32x2*)pr)[lane]; wk[u] = ((const unsigned*)(pr + 256))[lane];
                        if (row < TL) { if (lane < 16) { ka[u] = bf2f(pr[384 + lane]); kb[u] = bf2f(pr[400 + lane]); }
                            const bf16_t* q = pr + 928 + (lane >> 5) * 64; sa[u] = bf2f(q[lane & 31]); sb[u] = bf2f(q[32 + (lane & 31)]); } } }
#pragma unroll
                for (int u = 0; u < 2; ++u) if (ok[u]) { const int row = row0 + u * ngw; bf16_t* pr = PROJ + (size_t)row * PROJ_N;
                    { const u32x2 w = wq[u]; float v0 = bf2f(w.x & 0xffff), v1 = bf2f(w.x >> 16), v2 = bf2f(w.y & 0xffff), v3 = bf2f(w.y >> 16);
                      const float rstd = 1.0f / sqrtf(wave_sum(v0 * v0 + v1 * v1 + v2 * v2 + v3 * v3) * (1.f / 256.f) + EPSV); const f32x4 g = ((const f32x4*)IN(I_QNORM))[lane];
                      u32x2 o; o.x = cvtpk(v0 * rstd * g.x, v1 * rstd * g.y); o.y = cvtpk(v2 * rstd * g.z, v3 * rstd * g.w); ((u32x2*)(CN + (size_t)row * CN_N))[lane] = o; }
                    { const unsigned w = wk[u]; float v0 = bf2f(w & 0xffff), v1 = bf2f(w >> 16);
                      const float rstd = 1.0f / sqrtf(wave_sum(v0 * v0 + v1 * v1) * (1.f / 128.f) + EPSV); const float g0 = IN(I_KVNORM)[2 * lane], g1 = IN(I_KVNORM)[2 * lane + 1];
                      ((unsigned*)(CN + (size_t)row * CN_N + 256))[lane] = cvtpk(v0 * rstd * g0, v1 * rstd * g1); }
                    if (row < TL) { const int pos = row & 8191, rr = pos >> 6, cc = pos & 63;
                        if (lane < 16) { const int i = lane, p = i < 8 ? rr : cc, f = i & 7; const float c = ROPE[p * 8 + f], sn = ROPE[1024 + p * 8 + f]; const float a_ = ka[u], b_ = kb[u];
                            pr[384 + i] = (bf16_t)f2bf(a_ * c - b_ * sn); pr[400 + i] = (bf16_t)f2bf(a_ * sn + b_ * c); }
                        { const int hd = lane >> 5, i = lane & 31, p = i < 16 ? rr : cc, f = i & 15; const float c = ROPE[2048 + p * 16 + f], sn = ROPE[4096 + p * 16 + f]; bf16_t* q = pr + 928 + hd * 64;
                            const float a_ = sa[u], b_ = sb[u]; q[i] = (bf16_t)f2bf(a_ * c - b_ * sn); q[32 + i] = (bf16_t)f2bf(a_ * sn + b_ * c); } } }
            } }
            GSYNC();
            { pg8::EpiBf16 e{QKV, QKV_N}; RUN_GEMM(pg8::EpiBf16, e, CN, WUT, TA, QKV_N, CN_N, CN_N, CN_N, NOGRP, 0); }
            GSYNC();
            {
                const float scA = 0.10206207261596577f * LOG2E, scB = 0.125f * LOG2E;
                for (int rep_ = 0; rep_ < PROBE_ATT; ++rep_) {
                for (int u = vcu; u < 2048; u += G) { const int bh = u >> 5, qb = u & 31, b = bh >> 3, hd = bh & 7; const size_t lrow = (size_t)b * SEQ, crow_ = (size_t)TL + b * CTXN;
                    attn_unit<96>(lds, QKV + (lrow + qb * 256) * QKV_N + hd * 96, QKV_N, QKV + crow_ * QKV_N + 768 + hd * 128, QKV + lrow * QKV_N + 768 + hd * 128, QKV_N,
                                  PROJ + crow_ * PROJ_N + 384, PROJ + lrow * PROJ_N + 384, PROJ_N, QKV + crow_ * QKV_N + 832 + hd * 128, QKV + lrow * QKV_N + 832 + hd * 128, QKV_N,
                                  Ab + (lrow + qb * 256) * D + hd * 64, D, 0, 128, false, qb * 256, scA, false, 0.f, 1, ROPE); }
                for (int u = vcu; u < 2048; u += G) { const int bh = u >> 5, qb = u & 31, b = bh >> 3, qh = bh & 7; const size_t lrow = (size_t)b * SEQ, crow_ = (size_t)TL + b * CTXN;
                    const int lo = (4 * qb - 2) < 0 ? 0 : 4 * qb - 2, hi = (4 * qb + 6) > 128 ? 128 : 4 * qb + 6;
                    attn_unit<64>(lds, PROJ + (lrow + qb * 256) * PROJ_N + 416 + qh * 64, PROJ_N, PROJ + crow_ * PROJ_N + 928 + (qh >> 2) * 64, PROJ + lrow * PROJ_N + 928 + (qh >> 2) * 64, PROJ_N,
                                  nullptr, nullptr, 0, PROJ + crow_ * PROJ_N + 1056 + (qh >> 2) * 64, PROJ + lrow * PROJ_N + 1056 + (qh >> 2) * 64, PROJ_N,
                                  Ab + (lrow + qb * 256) * D + 512 + qh * 64, D, lo, hi, true, qb * 256, scB, true, IN(I_SINK)[qh] * LOG2E, 2, ROPE); }
                for (int u = vcu; u < 64; u += G) { const int b = u >> 3, hd = u & 7; const size_t crow_ = (size_t)TL + b * CTXN;
                    attn_unit<96>(lds, QKV + crow_ * QKV_N + hd * 96, QKV_N, QKV + crow_ * QKV_N + 768 + hd * 128, QKV, QKV_N, PROJ + crow_ * PROJ_N + 384, PROJ, PROJ_N,
                                  QKV + crow_ * QKV_N + 832 + hd * 128, QKV, QKV_N, Ab + crow_ * D + hd * 64, D, 0, 0, false, 0, scA, false, 0.f, 0, ROPE);
                    attn_unit<64>(lds, PROJ + crow_ * PROJ_N + 416 + hd * 64, PROJ_N, PROJ + crow_ * PROJ_N + 928 + (hd >> 2) * 64, PROJ, PROJ_N, nullptr, nullptr, 0,
                                  PROJ + crow_ * PROJ_N + 1056 + (hd >> 2) * 64, PROJ, PROJ_N, Ab + crow_ * D + 512 + hd * 64, D, 0, 0, false, 0, scB, true, IN(I_SINK)[hd] * LOG2E, 0, ROPE); }
                }
            }
            GSYNC();
            { pg8::EpiBf16 e{Yb, D}; RUN_GEMM(pg8::EpiBf16, e, Ab, WOUTT, TA, 1024, 1024, 1024, 1024, NOGRP, 0); }
            GSYNC();
        } else {
            { TIDS
            const float* cre = IN(I_CRE); const float* cim = IN(I_CIM); const float* dsk = IN(I_S5D);
            for (int rep_ = 0; rep_ < PROBE_MISC; ++rep_) for (int i0 = gt; i0 < 64 * 1024 * 128; i0 += 4 * ngt) {
                f32x4 a0[4], a1[4], b0[4], b1[4]; float dg[4];
#pragma unroll
                for (int u = 0; u < 4; ++u) { const int i = i0 + u * ngt; if (i < 64 * 1024 * 128) { const int k8 = (i & 127) * 8, n = (i >> 7) & 1023, g = i >> 17, tp = n >> 4, hh = n & 15, sp = k8 >> 4, h0 = k8 & 15, dd = tp - sp, dA = dd > 0 ? dd : 0, dB = dd < 0 ? -dd : 0;
                    const f32x4* ka = (const f32x4*)(KTAB + ((((size_t)g * 2 + 0) * 64 + dA) * 16 + hh) * 16 + h0); const f32x4* kb = (const f32x4*)(KTAB + ((((size_t)g * 2 + 1) * 64 + dB) * 16 + hh) * 16 + h0);
                    a0[u] = ka[0]; a1[u] = ka[1]; b0[u] = kb[0]; b1[u] = kb[1]; dg[u] = (dd == 0) ? dsk[g * 16 + hh] : 0.f; } }
#pragma unroll
                for (int u = 0; u < 4; ++u) { const int i = i0 + u * ngt; if (i < 64 * 1024 * 128) { const int k8 = (i & 127) * 8, n = (i >> 7) & 1023, g = i >> 17, tp = n >> 4, hh = n & 15, sp = k8 >> 4, h0 = k8 & 15, dd = tp - sp; const float wa = dd >= 0 ? 1.f : 0.f, wb = dd <= 0 ? 1.f : 0.f; float v[8];
#pragma unroll
                    for (int j = 0; j < 4; ++j) { v[j] = wa * a0[u][j] + wb * b0[u][j] + ((h0 + j) == hh ? dg[u] : 0.f); v[4 + j] = wa * a1[u][j] + wb * b1[u][j] + ((h0 + 4 + j) == hh ? dg[u] : 0.f); }
                    u32x4 w; w.x = cvtpk(v[0], v[1]); w.y = cvtpk(v[2], v[3]); w.z = cvtpk(v[4], v[5]); w.w = cvtpk(v[6], v[7]); *(u32x4*)(BMm + ((size_t)g * 1024 + n) * XE_K + k8) = w; } } }
            for (int rep_ = 0; rep_ < PROBE_MISC; ++rep_) for (int i = gt; i < 64 * 1024 * 32; i += ngt) { const int kk = (i & 31) * 8, n = (i >> 5) & 1023, g = i >> 15, tp = n >> 4, hh = n & 15, dir = kk >> 7, ri = (kk >> 6) & 1, p0 = kk & 63, e = dir == 0 ? tp + 1 : 64 - tp; float v[8];
#pragma unroll
                for (int j = 0; j < 8; ++j) { const int p = p0 + j; const float pr = POW[(size_t)((dir * 64 + g) * 64 + p) * 130 + 2 * e], pi = POW[(size_t)((dir * 64 + g) * 64 + p) * 130 + 2 * e + 1];
                    const float cr = cre[((size_t)(dir * 64 + g) * 16 + hh) * 64 + p], ci = cim[((size_t)(dir * 64 + g) * 16 + hh) * 64 + p]; v[j] = ri == 0 ? cr * pr - ci * pi : -(cr * pi + ci * pr); }
                u32x4 w; w.x = cvtpk(v[0], v[1]); w.y = cvtpk(v[2], v[3]); w.z = cvtpk(v[4], v[5]); w.w = cvtpk(v[6], v[7]); *(u32x4*)(BMm + ((size_t)g * 1024 + n) * XE_K + 1024 + kk) = w; }
            for (int rep_ = 0; rep_ < PROBE_MISC; ++rep_) for (int i = gt; i < 64 * 256 * 128; i += ngt) { const int k8 = (i & 127) * 8, n = (i >> 7) & 255, g = i >> 15, dir = n >> 7, ri = (n >> 6) & 1, p = n & 63, sp = k8 >> 4, h0 = k8 & 15, e = dir == 0 ? 63 - sp : sp;
                const size_t ib = (size_t)((dir * 64 + g) * 64 + p); const float pr = POW[ib * 130 + 2 * e], pi = POW[ib * 130 + 2 * e + 1]; float v[8];
#pragma unroll
                for (int j = 0; j < 8; ++j) { const float br = BBAR[(ib * 16 + h0 + j) * 2], bi = BBAR[(ib * 16 + h0 + j) * 2 + 1]; v[j] = ri == 0 ? pr * br - pi * bi : pr * bi + pi * br; }
                u32x4 w; w.x = cvtpk(v[0], v[1]); w.y = cvtpk(v[2], v[3]); w.z = cvtpk(v[4], v[5]); w.w = cvtpk(v[6], v[7]); *(u32x4*)(BSm + ((size_t)g * 256 + n) * 1024 + k8) = w; }
            }
            { pg8::EpiS5In e{XE, UC}; RUN_GEMM(pg8::EpiS5In, e, Ab, S5INT, TA, 1024, 1024, 1024, 1024, NOGRP, 0); }
            GSYNC();
            { TIDS
            LAS float* su = (LAS float*)lds;
            for (int rep_ = 0; rep_ < PROBE_MISC; ++rep_) for (int pi0 = bx * 2; pi0 < 512; pi0 += G * 2) {
                __syncthreads();
#pragma unroll
                for (int k = 0; k < 4; ++k) { const int idx = tid + 512 * k, pr = idx >> 10, rem = idx & 1023, j = rem >> 2, q = rem & 3, pi = pi0 + pr;
                    if (pi < 512) ((LAS f32x4*)su)[idx] = *(const f32x4*)(UC + (size_t)((pi >> 6) * 256 + j) * D + (pi & 63) * 16 + 4 * q); }
                __syncthreads();
                if (wave < 4 && pi0 + (wave >> 1) < 512) { const int pi = pi0 + (wave >> 1), dir = wave & 1, b = pi >> 6, g = pi & 63, p = lane; const size_t ib = (size_t)((dir * 64 + g) * 64 + p);
                    const float are = ABAR[2 * ib], aim = ABAR[2 * ib + 1]; float br[16], bi[16];
#pragma unroll
                    for (int hh = 0; hh < 16; ++hh) { br[hh] = BBAR[(ib * 16 + hh) * 2]; bi[hh] = BBAR[(ib * 16 + hh) * 2 + 1]; }
                    float sr = 0.f, si = 0.f; const LAS f32x4* ub = (const LAS f32x4*)su + (wave >> 1) * 1024;
#pragma unroll 4
                    for (int jj = 0; jj < 256; ++jj) { const int j = dir == 0 ? jj : 255 - jj; const LAS f32x4* up = ub + j * 4; float ur = 0.f, ui = 0.f;
#pragma unroll
                        for (int q = 0; q < 4; ++q) { const f32x4 uv = up[q]; ur += uv.x * br[4 * q] + uv.y * br[4 * q + 1] + uv.z * br[4 * q + 2] + uv.w * br[4 * q + 3]; ui += uv.x * bi[4 * q] + uv.y * bi[4 * q + 1] + uv.z * bi[4 * q + 2] + uv.w * bi[4 * q + 3]; }
                        const float nr = are * sr - aim * si + ur, ni = are * si + aim * sr + ui; sr = nr; si = ni; }
                    SCTX[(((size_t)b * 64 + g) * 2 + dir) * 128 + p] = sr; SCTX[(((size_t)b * 64 + g) * 2 + dir) * 128 + 64 + p] = si; }
            }
            __syncthreads();
            }
            { pg8::EpiF32 e{Eb, 256}; RUN_GEMM(pg8::EpiF32, e, XE, BSm, 64 * 1024, 256, 1024, XE_K, 1024, 4, 256 * 1024); }
            GSYNC();
            { TIDS
            for (int rep_ = 0; rep_ < PROBE_MISC; ++rep_) for (int i = gt; i < 8 * 64 * 2 * 64; i += ngt) { const int p = i & 63, dir = (i >> 6) & 1, g = (i >> 7) & 63, b = i >> 13; const size_t ib = (size_t)((dir * 64 + g) * 64 + p);
                const float are = POW[ib * 130 + 128], aim = POW[ib * 130 + 129];
                float sr = SCTX[(((size_t)b * 64 + g) * 2 + dir) * 128 + p], si = SCTX[(((size_t)b * 64 + g) * 2 + dir) * 128 + 64 + p];
                for (int cb = 0; cb < 128; cb += 8) { float er[8], ei[8];
#pragma unroll
                    for (int u = 0; u < 8; ++u) { const int c = dir == 0 ? cb + u : 127 - (cb + u); const size_t row = (size_t)g * 1024 + b * 128 + c; er[u] = Eb[row * 256 + dir * 128 + p]; ei[u] = Eb[row * 256 + dir * 128 + 64 + p]; }
#pragma unroll
                    for (int u = 0; u < 8; ++u) { const int c = dir == 0 ? cb + u : 127 - (cb + u); const size_t row = (size_t)g * 1024 + b * 128 + c;
                        XE[row * XE_K + 1024 + dir * 128 + p] = (bf16_t)f2bf(sr); XE[row * XE_K + 1024 + dir * 128 + 64 + p] = (bf16_t)f2bf(si);
                        const float nr = are * sr - aim * si + er[u], ni = are * si + aim * sr + ei[u]; sr = nr; si = ni; } } }
            }
            GSYNC();
            { pg8::EpiS5Out e{Ab}; RUN_GEMM(pg8::EpiS5Out, e, XE, BMm, 64 * 1024, 1024, XE_K, XE_K, XE_K, 4, 1024 * XE_K); }
            GSYNC();
            { pg8::EpiGlu e{Yb}; RUN_GEMM(pg8::EpiGlu, e, Ab, GLUT, TL, 2048, 1024, 1024, 1024, NOGRP, 0); }
            GSYNC();
        }
        const int nr2 = l == 0 ? TA : TL;
        {
            TIDS
            RowOp o{HB, HCTX, true, HB, HCTX, true, Yb, npost + D, MODL, 5, 1.0f, npre + 2 * D, MODL, 6, 7, Ab, nr2};
            row_phase(o, gwx, ngw, lane);
        }
        GSYNC();
        for (int rep_ = 0; rep_ < PROBE_G1; ++rep_) { pg8::EpiSwiglu e{Ub}; RUN_GEMM(pg8::EpiSwiglu, e, Ab, W13T + (size_t)(l * 2 + 1) * 5632 * 1024, nr2, 5632, 1024, 1024, 1024, NOGRP, 0); }
        GSYNC();
        for (int rep_ = 0; rep_ < PROBE_G2; ++rep_) { pg8::EpiBf16 e{Yb, D}; RUN_GEMM(pg8::EpiBf16, e, Ub, W2T + (size_t)(l * 2 + 1) * 1024 * 2816, nr2, 1024, 2816, 2816, 2816, NOGRP, 0); }
        GSYNC();
        {
            TIDS
            RowOp o{HB, HCTX, true, l == 0 ? (void*)HB : (void*)OUT, HCTX, l == 0, Yb, npost + 2 * D, MODL, 8, 0.5f, l == 0 ? IN(I_NPRE) + 3 * D : nullptr, MOD1, 0, 1, Ab, nr2};
            row_phase(o, gwx, ngw, lane);
        }
        if (l == 0) GSYNC();
}

__global__ void __launch_bounds__(512, 2) fwd_megakernel(Args args) {
    extern __shared__ __attribute__((aligned(16))) unsigned char lds_raw[];
    LAS unsigned char* lds = (LAS unsigned char*)lds_raw;
    cg::grid_group grid = cg::this_grid();
    {
        if (threadIdx.x < 2) ((LAS unsigned*)(lds + XB_LDS_OFF))[threadIdx.x] = 0u;
        if (blockIdx.x == 0) { GAS unsigned* bw = (GAS unsigned*)args.ws; for (int i = threadIdx.x; i < XCD_BAR_WORDS; i += 512) bw[i] = 0u; }
        __syncthreads();
    }
    for (int rep_ = 0; rep_ < PROBE_MISC * PROBE_PRO; ++rep_) { prologue_phase(args, lds); __syncthreads(); }
    grid.sync();
    if (threadIdx.x == 0) (void)xb_add((unsigned*)args.ws + XB_XCNT(xb_xcc_id()), 1u);
    layer_phase<0>(args, lds, grid);
    layer_phase<1>(args, lds, grid);
}

extern "C" void kernel_launch(void* const* d_in, const int* in_sizes, int n_in, void* d_out, int out_size, void* d_ws, size_t ws_size, hipStream_t stream) {
    static int grid_blocks = 0;
    if (grid_blocks == 0) {
        if (n_in != 27 || out_size != TL * D || ws_size < WS_END) { fprintf(stderr, "kernel_launch: unexpected shapes (n_in %d out %d ws %zu)\n", n_in, out_size, ws_size); grid_blocks = -1; return; }
        int dev = 0, cus = 0, per_cu = 0;
        hipGetDevice(&dev);
        hipDeviceGetAttribute(&cus, hipDeviceAttributeMultiprocessorCount, dev);
        hipFuncSetAttribute((const void*)fwd_megakernel, hipFuncAttributeMaxDynamicSharedMemorySize, LDS_BYTES);
        hipOccupancyMaxActiveBlocksPerMultiprocessor(&per_cu, (const void*)fwd_megakernel, 512, LDS_BYTES);
        if (per_cu < 1) per_cu = 1;
        grid_blocks = cus * per_cu;
        (void)hipGetLastError();
    }
    if (grid_blocks < 0) return;
    Args a{};
    for (int i = 0; i < 27; ++i) a.in[i] = (const float*)d_in[i];
    a.out = (float*)d_out; a.ws = (unsigned char*)d_ws;
    void* kargs[] = {&a};
    hipError_t e = hipLaunchCooperativeKernel((const void*)fwd_megakernel, dim3(grid_blocks), dim3(512), kargs, LDS_BYTES, stream);
    if (e != hipSuccess) fprintf(stderr, "cooperative launch failed: %s (grid %d)\n", hipGetErrorString(e), grid_blocks);
}
```

```cpp
#include <hip/hip_runtime.h>
#include <hip/hip_cooperative_groups.h>
#include <cstdio>
#include <cstdint>
namespace cg = cooperative_groups;

#define LAS __attribute__((address_space(3)))
#define DI __device__ __forceinline__
typedef unsigned short bf16_t;
typedef short bf16x8 __attribute__((ext_vector_type(8)));
typedef short s16x4 __attribute__((ext_vector_type(4)));
typedef float f32x4 __attribute__((ext_vector_type(4)));
typedef float f32x16 __attribute__((ext_vector_type(16)));
typedef unsigned u32x4 __attribute__((ext_vector_type(4)));
typedef unsigned u32x2 __attribute__((ext_vector_type(2)));
typedef float f32x2_t __attribute__((ext_vector_type(2)));
typedef __bf16 bf16x2_t __attribute__((ext_vector_type(2)));

constexpr int D = 1024, FF = 2816, TL = 65536, TC = 2048, TA = TL + TC, SEQ = 8192, CTXN = 256, NBATCH = 8;
constexpr int PROJ_N = 1280, CN_N = 384, QKV_N = 1792, XE_K = 1280;
constexpr float EPSV = 1e-6f;
constexpr float LOG2E = 1.4426950408889634f;
constexpr size_t MiB = (size_t)1 << 20;
constexpr size_t WS_MOD = 1 * MiB, WS_ROPE = 2 * MiB, WS_ABAR = 3 * MiB, WS_BBAR = 4 * MiB, WS_POW = 5 * MiB, WS_KTAB = 10 * MiB, WS_SCTX = 18 * MiB;
constexpr size_t WS_W13T = 20 * MiB, WS_W2T = 64 * MiB, WS_WINT = 86 * MiB, WS_WUT = 89 * MiB, WS_WOUTT = 91 * MiB, WS_S5INT = 93 * MiB, WS_GLUT = 95 * MiB;
constexpr size_t WS_HCTX = 100 * MiB, WS_A = 108 * MiB, WS_Y = 240 * MiB, WS_SCR = 504 * MiB;
constexpr size_t WS_U = WS_SCR;
constexpr size_t WS_PROJ = WS_SCR, WS_CN = WS_SCR + 166 * MiB, WS_QKV = WS_SCR + 216 * MiB;
constexpr size_t WS_XE = WS_SCR, WS_UC = WS_SCR + 160 * MiB, WS_E = WS_SCR + 168 * MiB, WS_BM = WS_SCR + 232 * MiB, WS_BS = WS_SCR + 392 * MiB;
constexpr size_t WS_END = 1024 * MiB;
static_assert(WS_U + (size_t)TA * FF * 2 <= WS_END, "U");
static_assert(WS_PROJ + (size_t)TA * PROJ_N * 2 <= WS_CN && WS_CN + (size_t)TA * CN_N * 2 <= WS_QKV && WS_QKV + (size_t)TA * QKV_N * 2 <= WS_END, "attn scratch");
static_assert(WS_BS + (size_t)64 * 256 * 1024 * 2 <= WS_END && WS_BM + (size_t)64 * 1024 * XE_K * 2 <= WS_BS, "s5 scratch");
constexpr size_t WS_HB = 372 * MiB;
static_assert(WS_A + (size_t)TA * D * 2 <= WS_Y && WS_Y + (size_t)TA * D * 2 <= WS_HB && WS_HB + (size_t)TL * D * 2 <= WS_SCR, "A/Y/HB");
#ifndef PROBE_ATT
#define PROBE_ATT 1
#endif
#ifndef PROBE_PRO
#define PROBE_PRO 1
#endif
#ifndef PROBE_MISC
#define PROBE_MISC 1
#endif
#ifndef PROBE_SYNC
#define PROBE_SYNC 1
#endif
#ifndef PROBE_G1
#define PROBE_G1 1
#endif
#ifndef PROBE_G2
#define PROBE_G2 1
#endif
constexpr int LDS_BYTES = 147456;

#define GAS __attribute__((address_space(1)))
template <class T> DI T* gl(T* p) { return (T*)(GAS T*)p; }
DI unsigned f2bf(float f) { unsigned u = __builtin_bit_cast(unsigned, f); return (u + 0x7fffu + ((u >> 16) & 1u)) >> 16; }
DI unsigned cvtpk(float lo, float hi) { f32x2_t v = {lo, hi}; bf16x2_t b = __builtin_convertvector(v, bf16x2_t); return __builtin_bit_cast(unsigned, b); }
DI float bf2f(unsigned short b) { return __builtin_bit_cast(float, (unsigned)b << 16); }
DI float wave_sum(float v) {
    v += __builtin_bit_cast(float, __builtin_amdgcn_update_dpp(0, __builtin_bit_cast(int, v), 0xB1, 0xf, 0xf, true));
    v += __builtin_bit_cast(float, __builtin_amdgcn_update_dpp(0, __builtin_bit_cast(int, v), 0x4E, 0xf, 0xf, true));
    v += __builtin_bit_cast(float, __builtin_amdgcn_update_dpp(0, __builtin_bit_cast(int, v), 0x141, 0xf, 0xf, true));
    v += __builtin_bit_cast(float, __builtin_amdgcn_update_dpp(0, __builtin_bit_cast(int, v), 0x140, 0xf, 0xf, true));
    { auto rr = __builtin_amdgcn_permlane16_swap(__float_as_uint(v), __float_as_uint(v), false, false); v = __uint_as_float(rr[0]) + __uint_as_float(rr[1]); }
    { auto rr = __builtin_amdgcn_permlane32_swap(__float_as_uint(v), __float_as_uint(v), false, false); v = __uint_as_float(rr[0]) + __uint_as_float(rr[1]); }
    return v;
}
DI float sigm(float x) { return __builtin_amdgcn_rcpf(1.f + __expf(-x)); }
DI void sincos_rad_d(double ang, float& s, float& c) { double rev = ang * 0.15915494309189535; rev -= __builtin_rint(rev); const float f = (float)rev; s = __builtin_amdgcn_sinf(f); c = __builtin_amdgcn_cosf(f); }

namespace pg8 {
constexpr int BM = 256, BK = 64, HALF = 128, HTB = HALF * BK * 2, STAGE_BYTES = 8 * HTB, NXCD = 8, WGM = 8;
DI int lds_byte(int r, int c) { const int st = (r >> 4) * 2 + (c >> 5), rr = r & 15, cc = c & 31, ob = rr * 64 + cc * 2; return st * 1024 + (ob ^ (((ob >> 9) & 1) << 5)); }
DI void stage_rc(int b, int& R, int& C) { const int st = b / 1024, sb = b % 1024, swz = sb ^ (((sb >> 9) & 1) << 5); R = (st >> 1) * 16 + swz / 64; C = (st & 1) * 32 + (swz % 64) / 2; }
DI int perm32(int rho) { const int n = rho >> 4, i = rho & 15; return 8 * (i >> 2) + 4 * n + (i & 3); }
struct Unit { int pm, pn; };
struct Gemm { const bf16_t* A; const bf16_t* Bt; int M, N, K, lda, ldb, mt_per_group; size_t strideB; };
struct StaticOrder {
    int nM, nN, nwg, G, c;
    DI void init(int M, int N, int G_, int c_) { nM = M / BM; nN = N / BM; nwg = nM * nN; G = G_; c = c_; }
    DI bool next(int i, Unit& u) const {
        const long L = (long)i * G + c; if (L >= nwg) return false;
        int wgid = (int)L; { const int q = nwg / NXCD, r = nwg % NXCD, xcd = wgid % NXCD, off = wgid / NXCD; wgid = (xcd < r ? xcd * (q + 1) : r * (q + 1) + (xcd - r) * q) + off; }
        const int nig = WGM * nN, gid = wgid / nig, fm = gid * WGM, gsz = (nM - fm) < WGM ? (nM - fm) : WGM;
        u.pm = fm + ((wgid % nig) % gsz); u.pn = (wgid % nig) / gsz; return true;
    }
};
template <class Epi>
DI void gemm_phase(LAS unsigned char* lds, const Gemm g, const StaticOrder& S, const Epi& E) {
    int tid_ = threadIdx.x; asm volatile("" : "+v"(tid_));
    const int tid = tid_, wid = __builtin_amdgcn_readfirstlane(tid >> 6), lane = tid & 63, wr = wid >> 2, wc = wid & 3, fr = lane & 15, fq = lane >> 4;
    const int K = g.K, nt = K / BK;
    unsigned voffA[2], voffB[2];
#pragma unroll
    for (int i = 0; i < 2; ++i) { int R, C; stage_rc(tid * 16 + i * 8192, R, C); const int Rb = Epi::PERM ? ((R & ~31) + perm32(R & 31)) : R;
        voffA[i] = (unsigned)(R * g.lda + C) * 2u; voffB[i] = (unsigned)(Rb * g.ldb + C) * 2u; }
    const size_t kstep = (size_t)(BK * 2);
    const size_t hstepA = (size_t)HALF * g.lda * 2, hstepB = (size_t)HALF * g.ldb * 2, tstepA = 2 * hstepA, tstepB = 2 * hstepB;
    const unsigned ldsw = (unsigned)wid * 1024u;
    const int aoff = lds_byte(wr * 64 + fr, fq * 8), boff = lds_byte(wc * 32 + fr, fq * 8);
#define PG8_SA(b, h) (((b) * 2 + (h)) * HTB)
#define PG8_SB(b, h) ((4 + (b) * 2 + (h)) * HTB)
#define PG8_STAGE(bufoff, gbase, voff) do { _Pragma("unroll") for (int _i = 0; _i < 2; ++_i) \
        __builtin_amdgcn_global_load_lds((const unsigned*)((const char*)(gbase) + (voff)[_i]), (LAS unsigned*)(lds + (bufoff) + ldsw + _i * 8192), 16, 0, 0); } while (0)
#define PG8_LDA(dst, b, h) do { _Pragma("unroll") for (int m = 0; m < 4; ++m) _Pragma("unroll") for (int k = 0; k < 2; ++k) dst[m][k] = *(const LAS bf16x8*)(lds + PG8_SA(b, h) + aoff + m * 2048 + k * 1024); } while (0)
#define PG8_LDB(dst, b, h) do { _Pragma("unroll") for (int n = 0; n < 2; ++n) _Pragma("unroll") for (int k = 0; k < 2; ++k) dst[n][k] = *(const LAS bf16x8*)(lds + PG8_SB(b, h) + boff + n * 2048 + k * 1024); } while (0)
#define PG8_MMA(ai, bj, At, Bt) do { __builtin_amdgcn_s_setprio(1); _Pragma("unroll") for (int m = 0; m < 4; ++m) _Pragma("unroll") for (int n = 0; n < 2; ++n) _Pragma("unroll") for (int k = 0; k < 2; ++k) \
        acc[ai][bj][m][n] = __builtin_amdgcn_mfma_f32_16x16x32_bf16(Bt[n][k], At[m][k], acc[ai][bj][m][n], 0, 0, 0); __builtin_amdgcn_s_setprio(0); } while (0)
#define PG8_WAIT_V(n) asm volatile("s_waitcnt vmcnt(" #n ")" ::: "memory")
#define PG8_WAIT_L(n) asm volatile("s_waitcnt lgkmcnt(" #n ")" ::: "memory")
#define PG8_BAR __builtin_amdgcn_s_barrier()
#define PG8_SCHED __builtin_amdgcn_sched_barrier(0)
#define PG8_BPTR(u) ((const char*)g.Bt + (size_t)((u).pm / g.mt_per_group) * g.strideB * 2 + (size_t)(u).pn * tstepB)
    Unit cur, nxt; int ui = 0;
    if (!S.next(0, cur)) return;
    f32x4 acc[2][2][4][2];
#pragma unroll
    for (int a = 0; a < 2; ++a)
#pragma unroll
        for (int b = 0; b < 2; ++b)
#pragma unroll
            for (int m = 0; m < 4; ++m)
#pragma unroll
                for (int n = 0; n < 2; ++n) acc[a][b][m][n] = (f32x4){0.f, 0.f, 0.f, 0.f};
    bf16x8 At[4][2], B0[2][2], B1[2][2];
    const char* cA = (const char*)g.A + (size_t)cur.pm * tstepA; const char* cB = PG8_BPTR(cur);
    PG8_STAGE(PG8_SB(0, 0), cB, voffB); PG8_STAGE(PG8_SB(0, 1), cB + hstepB, voffB); PG8_STAGE(PG8_SA(0, 0), cA, voffA); PG8_STAGE(PG8_SA(0, 1), cA + hstepA, voffA);
    if (wr == 1) PG8_BAR;
    PG8_WAIT_V(2); PG8_BAR;
    PG8_STAGE(PG8_SB(1, 0), cB + kstep, voffB); PG8_STAGE(PG8_SA(1, 0), cA + kstep, voffA); PG8_STAGE(PG8_SB(1, 1), cB + hstepB + kstep, voffB);
    PG8_WAIT_V(6); PG8_BAR;
    for (;;) {
        const bool has_next = S.next(ui + 1, nxt);
        const char* nA = has_next ? (const char*)g.A + (size_t)nxt.pm * tstepA : cA; const char* nB = has_next ? PG8_BPTR(nxt) : cB;
        for (int t = 0; t < nt; t += 2) {
            const bool last = (t == nt - 2);
            const char* a1 = cA + (size_t)(t + 1) * kstep;
            const char* a2 = last ? nA : cA + (size_t)(t + 2) * kstep; const char* b2 = last ? nB : cB + (size_t)(t + 2) * kstep;
            const char* a3 = a2 + kstep; const char* b3 = b2 + kstep;
            PG8_LDB(B0, 0, 0); PG8_LDB(B1, 0, 1); PG8_SCHED; PG8_LDA(At, 0, 0); PG8_STAGE(PG8_SA(1, 1), a1 + hstepA, voffA);
            PG8_WAIT_V(8); PG8_WAIT_L(0); PG8_BAR; PG8_MMA(0, 0, At, B0); PG8_MMA(0, 1, At, B1); PG8_BAR; PG8_SCHED;
            PG8_LDA(At, 0, 1); PG8_STAGE(PG8_SB(0, 0), b2, voffB); PG8_STAGE(PG8_SB(0, 1), b2 + hstepB, voffB); PG8_STAGE(PG8_SA(0, 0), a2, voffA);
            PG8_WAIT_V(8); PG8_WAIT_L(0); PG8_BAR; PG8_MMA(1, 0, At, B0); PG8_MMA(1, 1, At, B1); PG8_BAR; PG8_SCHED;
            PG8_LDB(B0, 1, 0); PG8_LDB(B1, 1, 1); PG8_SCHED; PG8_LDA(At, 1, 0); PG8_STAGE(PG8_SA(0, 1), a2 + hstepA, voffA);
            PG8_WAIT_V(8); PG8_WAIT_L(0); PG8_BAR; PG8_MMA(0, 0, At, B0); PG8_MMA(0, 1, At, B1); PG8_BAR; PG8_SCHED;
            PG8_LDA(At, 1, 1); PG8_STAGE(PG8_SB(1, 0), b3, voffB); PG8_STAGE(PG8_SB(1, 1), b3 + hstepB, voffB); PG8_STAGE(PG8_SA(1, 0), a3, voffA);
            PG8_WAIT_V(8); PG8_WAIT_L(0); PG8_BAR; PG8_MMA(1, 0, At, B0); PG8_MMA(1, 1, At, B1); PG8_BAR; PG8_SCHED;
        }
        if (wr == 0) PG8_BAR;
        { int t2_ = threadIdx.x; asm volatile("" : "+v"(t2_)); const int w2_ = t2_ >> 6, l2_ = t2_ & 63; E(acc, cur, w2_ >> 2, w2_ & 3, l2_ & 15, l2_ >> 4); }
        if (!has_next) break;
#pragma unroll
        for (int a = 0; a < 2; ++a)
#pragma unroll
            for (int b = 0; b < 2; ++b)
#pragma unroll
                for (int m = 0; m < 4; ++m)
#pragma unroll
                    for (int n = 0; n < 2; ++n) acc[a][b][m][n] = (f32x4){0.f, 0.f, 0.f, 0.f};
        cur = nxt; cA = nA; cB = nB; ++ui;
        if (wr == 1) PG8_BAR;
    }
    PG8_WAIT_V(0);
    PG8_BAR;
#undef PG8_SA
#undef PG8_SB
#undef PG8_STAGE
#undef PG8_LDA
#undef PG8_LDB
#undef PG8_MMA
#undef PG8_WAIT_V
#undef PG8_WAIT_L
#undef PG8_BAR
#undef PG8_SCHED
#undef PG8_BPTR
}
typedef f32x4 Acc[2][2][4][2];
DI u32x4 pack8(const f32x4 v0, const f32x4 v1) { u32x4 w; w.x = cvtpk(v0[0], v0[1]); w.y = cvtpk(v0[2], v0[3]); w.z = cvtpk(v1[0], v1[1]); w.w = cvtpk(v1[2], v1[3]); return w; }
struct EpiBf16 {
    static constexpr bool PERM = true; bf16_t* O; int ldc;
    DI void operator()(const Acc& acc, const Unit& u, int wr, int wc, int fr, int fq) const {
        const int row0 = u.pm * BM + wr * 64 + fr, col0 = u.pn * BM + wc * 32 + 8 * fq;
#pragma unroll
        for (int ai = 0; ai < 2; ++ai)
#pragma unroll
            for (int m = 0; m < 4; ++m) { bf16_t* rowp = O + (size_t)(row0 + ai * HALF + m * 16) * ldc + col0;
#pragma unroll
                for (int bj = 0; bj < 2; ++bj) *(u32x4*)(rowp + bj * HALF) = pack8(acc[ai][bj][m][0], acc[ai][bj][m][1]); }
    }
};
struct EpiSwiglu {
    static constexpr bool PERM = true; bf16_t* O;
    DI void operator()(const Acc& acc, const Unit& u, int wr, int wc, int fr, int fq) const {
        const int row0 = u.pm * BM + wr * 64 + fr, col0 = u.pn * HALF + wc * 32 + 8 * fq;
#pragma unroll
        for (int ai = 0; ai < 2; ++ai)
#pragma unroll
            for (int m = 0; m < 4; ++m) { f32x4 r0, r1;
#pragma unroll
                for (int j = 0; j < 4; ++j) { const float g0 = acc[ai][0][m][0][j], g1 = acc[ai][0][m][1][j]; r0[j] = g0 * sigm(g0) * acc[ai][1][m][0][j]; r1[j] = g1 * sigm(g1) * acc[ai][1][m][1][j]; }
                *(u32x4*)(O + (size_t)(row0 + ai * HALF + m * 16) * FF + col0) = pack8(r0, r1); }
    }
};
struct EpiF32 {
    static constexpr bool PERM = false; float* O; int ldc;
    DI void operator()(const Acc& acc, const Unit& u, int wr, int wc, int fr, int fq) const {
        const int row0 = u.pm * BM + wr * 64 + fr, col0 = u.pn * BM + wc * 32 + 4 * fq;
#pragma unroll
        for (int ai = 0; ai < 2; ++ai)
#pragma unroll
            for (int m = 0; m < 4; ++m) { float* rowp = O + (size_t)(row0 + ai * HALF + m * 16) * ldc + col0;
#pragma unroll
                for (int bj = 0; bj < 2; ++bj)
#pragma unroll
                    for (int n = 0; n < 2; ++n) *(f32x4*)(rowp + bj * HALF + n * 16) = acc[ai][bj][m][n]; }
    }
};
struct EpiGlu {
    static constexpr bool PERM = true; bf16_t* O;
    DI void operator()(const Acc& acc, const Unit& u, int wr, int wc, int fr, int fq) const {
        const int row0 = u.pm * BM + wr * 64 + fr, col0 = u.pn * HALF + wc * 32 + 8 * fq;
#pragma unroll
        for (int ai = 0; ai < 2; ++ai)
#pragma unroll
            for (int m = 0; m < 4; ++m) { f32x4 r0, r1;
#pragma unroll
                for (int j = 0; j < 4; ++j) { r0[j] = acc[ai][0][m][0][j] * sigm(acc[ai][1][m][0][j]); r1[j] = acc[ai][0][m][1][j] * sigm(acc[ai][1][m][1][j]); }
                *(u32x4*)(O + (size_t)(row0 + ai * HALF + m * 16) * D + col0) = pack8(r0, r1); }
    }
};
struct EpiS5In {
    static constexpr bool PERM = true; bf16_t* XE; float* UC;
    DI void operator()(const Acc& acc, const Unit& u, int wr, int wc, int fr, int fq) const {
        const int row0 = u.pm * BM + wr * 64 + fr, col0 = u.pn * BM + wc * 32 + 8 * fq;
#pragma unroll
        for (int ai = 0; ai < 2; ++ai)
#pragma unroll
            for (int m = 0; m < 4; ++m) { const int row = row0 + ai * HALF + m * 16;
#pragma unroll
                for (int bj = 0; bj < 2; ++bj) { const int c8 = col0 + bj * HALF;
                    if (row < TL) { const int b = row >> 13, s = row & 8191, gi = c8 >> 4;
                        *(u32x4*)(XE + ((size_t)(gi * 1024 + b * 128 + (s >> 6)) * XE_K + (s & 63) * 16 + (c8 & 15))) = pack8(acc[ai][bj][m][0], acc[ai][bj][m][1]); }
                    else { float* p = UC + (size_t)(row - TL) * D + c8; *(f32x4*)p = acc[ai][bj][m][0]; *(f32x4*)(p + 4) = acc[ai][bj][m][1]; } } }
    }
};
struct EpiS5Out {
    static constexpr bool PERM = true; bf16_t* YG;
    DI void operator()(const Acc& acc, const Unit& u, int wr, int wc, int fr, int fq) const {
        const int row0 = u.pm * BM + wr * 64 + fr, col0 = u.pn * BM + wc * 32 + 8 * fq;
#pragma unroll
        for (int ai = 0; ai < 2; ++ai)
#pragma unroll
            for (int m = 0; m < 4; ++m) { const int rf = row0 + ai * HALF + m * 16, gi = rf >> 10, r = rf & 1023, b = r >> 7, c = r & 127;
#pragma unroll
                for (int bj = 0; bj < 2; ++bj) { const int n8 = col0 + bj * HALF, tp = n8 >> 4, ho = n8 & 15; f32x4 r0, r1;
#pragma unroll
                    for (int j = 0; j < 4; ++j) { const float y0 = acc[ai][bj][m][0][j], y1 = acc[ai][bj][m][1][j];
                        r0[j] = y0 * sigm(1.5957691216f * (y0 + 0.044715f * y0 * y0 * y0)); r1[j] = y1 * sigm(1.5957691216f * (y1 + 0.044715f * y1 * y1 * y1)); }
                    *(u32x4*)(YG + (size_t)(b * SEQ + c * 64 + tp) * D + gi * 16 + ho) = pack8(r0, r1); } }
    }
};
}

DI int crow(int i, int h) { return (i & 3) + 8 * (i >> 2) + 4 * h; }
DI bf16x8 rope_pair_lo(const bf16x8 x1, const bf16x8 x2, const float* cs, const float* sn, bf16x8& out2) {
    bf16x8 o1;
#pragma unroll
    for (int j = 0; j < 8; ++j) { const float a = bf2f((unsigned short)x1[j]), b = bf2f((unsigned short)x2[j]), c = cs[j], s = sn[j];
        o1[j] = (short)f2bf(a * c - b * s); out2[j] = (short)f2bf(a * s + b * c); }
    return o1;
}
template <int DQK>
DI void attn_unit(LAS unsigned char* lds, const bf16_t* Qrow0, int qpitch,
                  const bf16_t* KA_ctx, const bf16_t* KA_lat, int pA, const bf16_t* KB_ctx, const bf16_t* KB_lat, int pB,
                  const bf16_t* V_ctx, const bf16_t* V_lat, int pV, bf16_t* Orow0, int opitch,
                  int t_lo2, int t_hi2, bool band, int q0, float sc, bool has_sink, float sink_l2, int rope, const float* ropeT) {
    constexpr int NCH = DQK / 8, KP = DQK + 8, VP = 96, ND = DQK / 16;
    constexpr int KBUF = 64 * KP * 2, VBUF = 64 * VP * 2, VOFF = 2 * KBUF;
    int tid_ = threadIdx.x; asm volatile("" : "+v"(tid_));
    const int tid = tid_, lane = tid & 63, wid = __builtin_amdgcn_readfirstlane(tid >> 6), r = lane & 31, h = lane >> 5;
    bf16x8 qf[ND];
    { const bf16_t* qrow = Qrow0 + (size_t)(wid * 32 + r) * qpitch;
#pragma unroll
      for (int d0 = 0; d0 < ND; ++d0) qf[d0] = *(const bf16x8*)(qrow + 16 * d0 + 8 * h);
      if (rope) { const int pos = q0 + wid * 32 + r, rr = pos >> 6, cc = pos & 63;
        if (DQK == 96) { const float* cA = ropeT; const float* sA = ropeT + 1024; const int p = h ? cc : rr;
            bf16x8 o2; const bf16x8 o1 = rope_pair_lo(qf[ND - 2], qf[ND - 1], cA + p * 8, sA + p * 8, o2); qf[ND - 2] = o1; qf[ND - 1] = o2; }
        else { const float* cB = ropeT + 2048; const float* sB = ropeT + 4096;
            bf16x8 o2; bf16x8 o1 = rope_pair_lo(qf[0], qf[2], cB + rr * 16 + 8 * h, sB + rr * 16 + 8 * h, o2); qf[0] = o1; qf[2] = o2;
            o1 = rope_pair_lo(qf[1], qf[3], cB + cc * 16 + 8 * h, sB + cc * 16 + 8 * h, o2); qf[1] = o1; qf[3] = o2; } }
#pragma unroll
      for (int d0 = 0; d0 < ND; ++d0) { u32x4 w;
#pragma unroll
        for (int j = 0; j < 4; ++j) w[j] = cvtpk(bf2f((unsigned short)qf[d0][2 * j]) * sc, bf2f((unsigned short)qf[d0][2 * j + 1]) * sc);
        qf[d0] = __builtin_bit_cast(bf16x8, w); } }
    const int ntl = 4 + (t_hi2 - t_lo2);
    const bool k1v = (tid + 512) < 64 * NCH;
    const int grp = wid >> 2;
    u32x4 kr0, kr1 = (u32x4){0u, 0u, 0u, 0u}, vr;
#define AT_LOADK(t) do { const bool ic_ = (t) < 4; const int rb_ = ic_ ? (t) * 64 : (t_lo2 + (t) - 4) * 64; \
        { const int ch_ = tid, row_ = ch_ / NCH, c_ = ch_ % NCH; const bf16_t* s_ = (DQK == 64 || c_ < 8) ? (ic_ ? KA_ctx : KA_lat) + (size_t)(rb_ + row_) * pA + c_ * 8 : (ic_ ? KB_ctx : KB_lat) + (size_t)(rb_ + row_) * pB + (c_ - 8) * 8; kr0 = *(const u32x4*)s_; } \
        if (k1v) { const int ch_ = tid + 512, row_ = ch_ / NCH, c_ = ch_ % NCH; const bf16_t* s_ = (DQK == 64 || c_ < 8) ? (ic_ ? KA_ctx : KA_lat) + (size_t)(rb_ + row_) * pA + c_ * 8 : (ic_ ? KB_ctx : KB_lat) + (size_t)(rb_ + row_) * pB + (c_ - 8) * 8; kr1 = *(const u32x4*)s_; } } while (0)
#define AT_LOADV(t) do { const bool ic_ = (t) < 4; const int rb_ = ic_ ? (t) * 64 : (t_lo2 + (t) - 4) * 64; \
        { const int row_ = tid >> 3, c_ = tid & 7; vr = *(const u32x4*)((ic_ ? V_ctx : V_lat) + (size_t)(rb_ + row_) * pV + c_ * 8); } } while (0)
#define AT_STOREK(buf) do { { const int ch_ = tid, row_ = ch_ / NCH, c_ = ch_ % NCH; *(LAS u32x4*)(lds + (buf) * KBUF + (row_ * KP + c_ * 8) * 2) = kr0; } \
        if (k1v) { const int ch_ = tid + 512, row_ = ch_ / NCH, c_ = ch_ % NCH; *(LAS u32x4*)(lds + (buf) * KBUF + (row_ * KP + c_ * 8) * 2) = kr1; } } while (0)
#define AT_STOREV(buf) do { const int row_ = tid >> 3, c_ = tid & 7; *(LAS u32x4*)(lds + VOFF + (buf) * VBUF + (row_ * VP + c_ * 8) * 2) = vr; } while (0)
    float m_run = has_sink ? sink_l2 : 0.f, l_run = (has_sink && h == 0) ? 1.f : 0.f;
    bool started = false;
    f32x16 o0, o1, p0, p1, negm;
#pragma unroll
    for (int i = 0; i < 16; ++i) { o0[i] = 0.f; o1[i] = 0.f; p0[i] = 0.f; p1[i] = 0.f; negm[i] = -m_run; }
    bf16x8 pa[2][2];
#pragma unroll
    for (int a = 0; a < 2; ++a)
#pragma unroll
        for (int b = 0; b < 2; ++b) pa[a][b] = (bf16x8){0, 0, 0, 0, 0, 0, 0, 0};
    const int qw = q0 + wid * 32;
    const int vlane = (((lane & 15) >> 2) * VP + 16 * ((lane >> 4) & 1)) * 2 + 8 * (lane & 3) + (4 * h) * VP * 2;
    AT_LOADK(0); AT_STOREK(0);
    if (1 < ntl) AT_LOADK(1);
    AT_LOADV(0);
    __syncthreads();
    if (grp == 1) __syncthreads();
    bool act = false, act_prev = false; int kt0 = 0;
    for (int t = 0; t <= ntl; ++t) {
        if (t + 1 < ntl) AT_STOREK((t + 1) & 1);
        if (t < ntl) AT_STOREV(t & 1);
        if (t + 2 < ntl) AT_LOADK(t + 2);
        if (t + 1 < ntl) AT_LOADV(t + 1);
        if (t >= 1 && act_prev) {
            const LAS unsigned char* Vb = lds + VOFF + ((t - 1) & 1) * VBUF;
#pragma unroll
            for (int kb = 0; kb < 2; ++kb)
#pragma unroll
                for (int s = 0; s < 2; ++s) {
                    const LAS unsigned char* vb = Vb + vlane + (kb * 32 + 16 * s) * VP * 2;
#pragma unroll
                    for (int db = 0; db < 2; ++db) {
                        const s16x4 lo = __builtin_bit_cast(s16x4, __builtin_amdgcn_ds_read_tr16_b64_v4i16((LAS s16x4*)(vb + db * 64)));
                        const s16x4 hi = __builtin_bit_cast(s16x4, __builtin_amdgcn_ds_read_tr16_b64_v4i16((LAS s16x4*)(vb + db * 64 + 8 * VP * 2)));
                        const bf16x8 vf = __builtin_shufflevector(lo, hi, 0, 1, 2, 3, 4, 5, 6, 7);
                        if (db == 0) o0 = __builtin_amdgcn_mfma_f32_32x32x16_bf16(vf, pa[kb][s], o0, 0, 0, 0);
                        else o1 = __builtin_amdgcn_mfma_f32_32x32x16_bf16(vf, pa[kb][s], o1, 0, 0, 0);
                    }
                }
        }
        act = false;
        if (t < ntl) {
            act = true;
            if (band && t >= 4) { kt0 = (t_lo2 + t - 4) * 64; act = (kt0 + 63 >= qw - 128) && (kt0 <= qw + 31 + 128); }
            if (act) {
                const LAS unsigned char* Kb = lds + (t & 1) * KBUF;
#pragma unroll
                for (int d0 = 0; d0 < ND; ++d0) {
                    const bf16x8 k0 = *(const LAS bf16x8*)(Kb + (r * KP + 16 * d0 + 8 * h) * 2);
                    const bf16x8 k1 = *(const LAS bf16x8*)(Kb + ((32 + r) * KP + 16 * d0 + 8 * h) * 2);
                    if (d0 == 0) { p0 = __builtin_amdgcn_mfma_f32_32x32x16_bf16(k0, qf[d0], negm, 0, 0, 0); p1 = __builtin_amdgcn_mfma_f32_32x32x16_bf16(k1, qf[d0], negm, 0, 0, 0); }
                    else { p0 = __builtin_amdgcn_mfma_f32_32x32x16_bf16(k0, qf[d0], p0, 0, 0, 0); p1 = __builtin_amdgcn_mfma_f32_32x32x16_bf16(k1, qf[d0], p1, 0, 0, 0); }
                }
            }
        }
        __syncthreads();
        if (act) {
            if (band && t >= 4) { const int qpos = qw + r;
#pragma unroll
                for (int i = 0; i < 16; ++i) { const int kp = kt0 + crow(i, h); int d = qpos - kp; d = d < 0 ? -d : d; if (d > 128) p0[i] = -1e30f; int d2 = qpos - kp - 32; d2 = d2 < 0 ? -d2 : d2; if (d2 > 128) p1[i] = -1e30f; } }
            f32x16 e0, e1; unsigned um = 0u;
#pragma unroll
            for (int i = 0; i < 16; ++i) { e0[i] = __builtin_amdgcn_exp2f(p0[i]); e1[i] = __builtin_amdgcn_exp2f(p1[i]); const unsigned a = __float_as_uint(e0[i]), b = __float_as_uint(e1[i]); um = um > a ? um : a; um = um > b ? um : b; }
            { auto rr = __builtin_amdgcn_permlane32_swap(um, um, false, false); um = rr[0] > rr[1] ? rr[0] : rr[1]; }
            if (!started || __any(um > 0x43800000u)) {
                float mx = fmaxf(p0[0], p1[0]);
#pragma unroll
                for (int i = 1; i < 16; ++i) mx = fmaxf(mx, fmaxf(p0[i], p1[i]));
                { auto rr = __builtin_amdgcn_permlane32_swap(__float_as_uint(mx), __float_as_uint(mx), false, false); mx = fmaxf(__uint_as_float(rr[0]), __uint_as_float(rr[1])); }
                float alpha = 1.f;
                if (started || has_sink) { mx = fmaxf(mx, 0.f); alpha = __builtin_amdgcn_exp2f(-mx); }
                m_run += mx; l_run *= alpha;
#pragma unroll
                for (int i = 0; i < 16; ++i) { o0[i] *= alpha; o1[i] *= alpha; e0[i] = __builtin_amdgcn_exp2f(p0[i] - mx); e1[i] = __builtin_amdgcn_exp2f(p1[i] - mx); negm[i] = -m_run; }
                started = true;
            }
            float sum = 0.f;
#pragma unroll
            for (int i = 0; i < 16; ++i) { sum += e0[i] + e1[i]; p0[i] = e0[i]; p1[i] = e1[i]; }
            l_run += sum;
#pragma unroll
            for (int s = 0; s < 2; ++s) { u32x4 w; w.x = cvtpk(p0[8 * s], p0[8 * s + 1]); w.y = cvtpk(p0[8 * s + 2], p0[8 * s + 3]); w.z = cvtpk(p0[8 * s + 4], p0[8 * s + 5]); w.w = cvtpk(p0[8 * s + 6], p0[8 * s + 7]); pa[0][s] = __builtin_bit_cast(bf16x8, w);
                u32x4 w2; w2.x = cvtpk(p1[8 * s], p1[8 * s + 1]); w2.y = cvtpk(p1[8 * s + 2], p1[8 * s + 3]); w2.z = cvtpk(p1[8 * s + 4], p1[8 * s + 5]); w2.w = cvtpk(p1[8 * s + 6], p1[8 * s + 7]); pa[1][s] = __builtin_bit_cast(bf16x8, w2); }
        }
        act_prev = act;
        __syncthreads();
    }
    if (grp == 0) __syncthreads();
#undef AT_LOADK
#undef AT_LOADV
#undef AT_STOREK
#undef AT_STOREV
    const float lt = l_run + __shfl_xor(l_run, 32), inv = 1.f / lt;
    bf16_t* orow = Orow0 + (size_t)(wid * 32 + r) * opitch;
#pragma unroll
    for (int g = 0; g < 4; ++g) {
        u32x2 w; w.x = cvtpk(o0[4 * g] * inv, o0[4 * g + 1] * inv); w.y = cvtpk(o0[4 * g + 2] * inv, o0[4 * g + 3] * inv); *(u32x2*)(orow + 8 * g + 4 * h) = w;
        u32x2 w2; w2.x = cvtpk(o1[4 * g] * inv, o1[4 * g + 1] * inv); w2.y = cvtpk(o1[4 * g + 2] * inv, o1[4 * g + 3] * inv); *(u32x2*)(orow + 32 + 8 * g + 4 * h) = w2;
    }
}


#define XB_TMO      128
#define XB_XCNT(j)  (256  + 64 * (j))
#define XB_XSUB(j)  (1280 + 64 * (j))
#define XB_XGEN(j)  (2304 + 64 * (j))
#define XB_TOP      3328
#define XB_TOPGEN   3392
#define XCD_BAR_WORDS 3456
#define XB_SPIN_CAP (1u << 18)
DI unsigned xb_ld(unsigned* p)              { return __hip_atomic_load(p, __ATOMIC_RELAXED, __HIP_MEMORY_SCOPE_AGENT); }
DI unsigned xb_add(unsigned* p, unsigned v) { return __hip_atomic_fetch_add(p, v, __ATOMIC_RELAXED, __HIP_MEMORY_SCOPE_AGENT); }
DI unsigned xb_xcc_id() { return (unsigned)__builtin_amdgcn_s_getreg((3 << 11) | 20) & 0xFu; }
#define XB_SPIN(cond, bar) do { unsigned _sp = 0; while (cond) { __builtin_amdgcn_s_sleep(1); \
    if ((++_sp & 255u) == 0u) { if (xb_ld(&(bar)[XB_TMO])) break; if (_sp > XB_SPIN_CAP) { atomicAdd(&(bar)[XB_TMO], 1u); break; } } } } while (0)
struct XcdBarrier { unsigned* bar; unsigned x; volatile LAS unsigned* st; };
DI void xcd_barrier_complete(unsigned* bar, unsigned x, unsigned& nloc, unsigned& nx) {
    const unsigned G = gridDim.x * gridDim.y * gridDim.z;
    unsigned sum, cnt, mine, sp = 0u;
    for (;;) {
        sum = 0u; cnt = 0u; mine = 0u;
#pragma unroll
        for (unsigned j = 0; j < 16; ++j) { const unsigned c = xb_ld(&bar[XB_XCNT(j)]); sum += c; cnt += (c > 0u) ? 1u : 0u; mine = (j == x) ? c : mine; }
        if (sum == G) break;
        __builtin_amdgcn_s_sleep(1);
        if ((++sp & 255u) == 0u) { if (xb_ld(&bar[XB_TMO])) break; if (sp > XB_SPIN_CAP) { atomicAdd(&bar[XB_TMO], 1u); break; } }
    }
    nloc = mine > 0u ? mine : 1u; nx = cnt > 0u ? cnt : 1u;
}
DI void xcd_barrier(const XcdBarrier& b) {
    asm volatile("s_waitcnt vmcnt(0)" ::: "memory");
    __syncthreads();
    if (threadIdx.x == 0) {
        unsigned* bar = b.bar;
        __builtin_amdgcn_s_waitcnt(0);
        unsigned nloc = b.st[0], nx = b.st[1];
        if (nloc == 0u) { xcd_barrier_complete(bar, b.x, nloc, nx); b.st[0] = nloc; b.st[1] = nx; }
        const unsigned old = xb_add(&bar[XB_XSUB(b.x)], 1u);
        const unsigned gen = old / nloc;
        if (old + 1u == (gen + 1u) * nloc) {
            __builtin_amdgcn_fence(__ATOMIC_RELEASE, "agent");
            asm volatile("s_waitcnt vmcnt(0)" ::: "memory");
            const unsigned og = xb_add(&bar[XB_TOP], 1u);
            const unsigned tg = og / nx;
            if (og + 1u == (tg + 1u) * nx) xb_add(&bar[XB_TOPGEN], 1u);
            else XB_SPIN(xb_ld(&bar[XB_TOPGEN]) == tg, bar);
            __builtin_amdgcn_fence(__ATOMIC_ACQUIRE, "agent");
            xb_add(&bar[XB_XGEN(b.x)], 1u);
            asm volatile("s_waitcnt vmcnt(0)" ::: "memory");
        } else {
            XB_SPIN(xb_ld(&bar[XB_XGEN(b.x)]) == gen, bar);
            __builtin_amdgcn_fence(__ATOMIC_ACQUIRE, "agent");
            asm volatile("s_waitcnt vmcnt(0)" ::: "memory");
        }
    }
    __syncthreads();
}
constexpr int XB_LDS_OFF = 131072 + 64;

struct Args { const float* in[27]; float* out; unsigned char* ws; };
enum { I_X = 0, I_C, I_CTX, I_CCTX, I_MODW, I_MODB, I_NPRE, I_NPOST, I_W13, I_W2, I_AWIN, I_QNORM, I_WUQ, I_KVNORM, I_WUKV, I_SINK, I_AWOUT, I_S5WIN, I_LRE, I_LIM, I_BRE, I_BIM, I_CRE, I_CIM, I_LSTEP, I_S5D, I_WGLU };

DI void transpose_item(const float* W, int N, bf16_t* WT, int ldk, int koff, int drow0, LAS float* scr, int k0, int n0, int lane) {
#pragma unroll 8
    for (int i = 0; i < 32; ++i) { const int kk = 2 * i + (lane >> 5); scr[kk * 33 + (lane & 31)] = W[(size_t)(k0 + kk) * N + n0 + (lane & 31)]; }
    asm volatile("s_waitcnt lgkmcnt(0)" ::: "memory");
    const int c = lane & 7;
#pragma unroll
    for (int j = 0; j < 4; ++j) { const int n = (lane >> 3) + 8 * j; const LAS float* s = scr + (8 * c) * 33 + n;
        u32x4 o; o.x = cvtpk(s[0 * 33], s[1 * 33]); o.y = cvtpk(s[2 * 33], s[3 * 33]); o.z = cvtpk(s[4 * 33], s[5 * 33]); o.w = cvtpk(s[6 * 33], s[7 * 33]);
        *(u32x4*)(WT + (size_t)(drow0 + n) * ldk + koff + k0 + 8 * c) = o; }
    asm volatile("s_waitcnt lgkmcnt(0)" ::: "memory");
}
DI int pairmap(int n0, int split) { const int jj = n0 < split ? n0 : n0 - split; return (jj >> 7) * 256 + (n0 < split ? 0 : 128) + (jj & 127); }

struct RowOp {
    const void* hin_lat; const void* hin_ctx; bool hin_bf16; void* hout_lat; void* hout_ctx; bool hout_bf16;
    const bf16_t* Y; const float* g_post; const float* modg; int gate_idx; float coef;
    const float* g_pre; const float* modp; int shift_idx, scale_idx; bf16_t* A; int nrows;
};
DI void unpack8(const u32x4 w, float* v) {
#pragma unroll
    for (int e = 0; e < 4; ++e) { v[2 * e] = __builtin_bit_cast(float, w[e] << 16); v[2 * e + 1] = __builtin_bit_cast(float, w[e] & 0xffff0000u); }
}
DI void ld16(const float* v, int lane, float* d) {
    const f32x4* p = (const f32x4*)v;
#pragma unroll
    for (int j = 0; j < 2; ++j)
#pragma unroll
        for (int q = 0; q < 2; ++q) { const f32x4 x = p[2 * lane + q + 128 * j];
#pragma unroll
            for (int e = 0; e < 4; ++e) d[8 * j + 4 * q + e] = x[e]; }
}
DI void row_phase(const RowOp& o, int gw, int ngw, int lane) {
    const int chunk = (o.nrows + ngw - 1) / ngw, rbeg = gw * chunk, rend = (rbeg + chunk) < o.nrows ? (rbeg + chunk) : o.nrows;
    float gpo[16], gpr[16], gat[16], shf[16], scl[16]; int cur = -1;
#pragma unroll
    for (int e = 0; e < 16; ++e) { gpo[e] = 0.f; gpr[e] = 0.f; gat[e] = 0.f; shf[e] = 0.f; scl[e] = 0.f; }
    if (o.Y) ld16(o.g_post, lane, gpo);
    if (o.g_pre) ld16(o.g_pre, lane, gpr);
    for (int row0 = rbeg; row0 < rend; row0 += 4) {
        float hv[4][16], yv[4][16]; bool ok[4]; int rows[4];
#pragma unroll
        for (int u = 0; u < 4; ++u) { const int row = row0 + u; rows[u] = row; ok[u] = row < rend;
            if (ok[u]) { const size_t roff = row < TL ? (size_t)row * D : (size_t)(row - TL) * D;
                if (o.hin_bf16) { const u32x4* hp = (const u32x4*)((const bf16_t*)(row < TL ? o.hin_lat : o.hin_ctx) + roff);
#pragma unroll
                    for (int j = 0; j < 2; ++j) unpack8(hp[lane + 64 * j], &hv[u][8 * j]); }
                else { const f32x4* hp = (const f32x4*)((const float*)(row < TL ? o.hin_lat : o.hin_ctx) + roff);
#pragma unroll
                    for (int j = 0; j < 2; ++j) { const f32x4 a = hp[2 * lane + 128 * j], b = hp[2 * lane + 1 + 128 * j];
#pragma unroll
                        for (int e = 0; e < 4; ++e) { hv[u][8 * j + e] = a[e]; hv[u][8 * j + 4 + e] = b[e]; } } }
                if (o.Y) { const u32x4* yp = (const u32x4*)(o.Y + (size_t)row * D);
#pragma unroll
                    for (int j = 0; j < 2; ++j) unpack8(yp[lane + 64 * j], &yv[u][8 * j]); } } }
#pragma unroll
        for (int u = 0; u < 4; ++u) if (ok[u]) { const int row = rows[u]; const int mrow = row < TL ? (row >> 13) : 8; const size_t roff = row < TL ? (size_t)row * D : (size_t)(row - TL) * D;
            if (mrow != cur) { cur = mrow;
                if (o.Y) { ld16(o.modg + (size_t)mrow * 9216 + o.gate_idx * D, lane, gat);
#pragma unroll
                    for (int e = 0; e < 16; ++e) gat[e] *= o.coef; }
                if (o.g_pre) { ld16(o.modp + (size_t)mrow * 9216 + o.shift_idx * D, lane, shf); ld16(o.modp + (size_t)mrow * 9216 + o.scale_idx * D, lane, scl);
#pragma unroll
                    for (int e = 0; e < 16; ++e) scl[e] += 1.0f; } }
            if (o.Y) {
                float ss = 0.f;
#pragma unroll
                for (int e = 0; e < 16; ++e) ss += yv[u][e] * yv[u][e];
                const float rstd = 1.0f / sqrtf(wave_sum(ss) * (1.f / D) + EPSV);
#pragma unroll
                for (int e = 0; e < 16; ++e) hv[u][e] += gat[e] * (yv[u][e] * rstd * gpo[e]);
                if (o.hout_bf16) { u32x4* op = (u32x4*)((bf16_t*)(row < TL ? o.hout_lat : o.hout_ctx) + roff);
#pragma unroll
                    for (int j = 0; j < 2; ++j) { u32x4 w;
#pragma unroll
                        for (int e = 0; e < 4; ++e) w[e] = cvtpk(hv[u][8 * j + 2 * e], hv[u][8 * j + 2 * e + 1]);
                        op[lane + 64 * j] = w; unpack8(w, &hv[u][8 * j]); } }
                else { f32x4* op = (f32x4*)((float*)(row < TL ? o.hout_lat : o.hout_ctx) + roff);
#pragma unroll
                    for (int j = 0; j < 2; ++j) { op[2 * lane + 128 * j] = (f32x4){hv[u][8 * j], hv[u][8 * j + 1], hv[u][8 * j + 2], hv[u][8 * j + 3]}; op[2 * lane + 1 + 128 * j] = (f32x4){hv[u][8 * j + 4], hv[u][8 * j + 5], hv[u][8 * j + 6], hv[u][8 * j + 7]}; } }
            }
            if (o.g_pre) {
                float ss = 0.f;
#pragma unroll
                for (int e = 0; e < 16; ++e) ss += hv[u][e] * hv[u][e];
                const float rstd = 1.0f / sqrtf(wave_sum(ss) * (1.f / D) + EPSV);
                u32x4* ap = (u32x4*)(o.A + (size_t)row * D);
#pragma unroll
                for (int j = 0; j < 2; ++j) { u32x4 w;
#pragma unroll
                    for (int e = 0; e < 4; ++e) w[e] = cvtpk((hv[u][8 * j + 2 * e] * rstd * gpr[8 * j + 2 * e]) * scl[8 * j + 2 * e] + shf[8 * j + 2 * e], (hv[u][8 * j + 2 * e + 1] * rstd * gpr[8 * j + 2 * e + 1]) * scl[8 * j + 2 * e + 1] + shf[8 * j + 2 * e + 1]);
                    ap[lane + 64 * j] = w; }
            }
        }
    }
}

#define KSETUP \
    const int G = gridDim.x, bx = blockIdx.x; \
    const int ngw = G * 8, ngt = G * 512; \
    const int vcu = (G % 8 == 0) ? (bx % 8) * (G / 8) + bx / 8 : bx; \
    GAS unsigned char* wsg_ = (GAS unsigned char*)args.ws; asm volatile("" : "+s"(wsg_)); unsigned char* ws = (unsigned char*)wsg_; \
    float* MOD = (float*)(ws + WS_MOD); float* ROPE = (float*)(ws + WS_ROPE); \
    float* ABAR = (float*)(ws + WS_ABAR); float* BBAR = (float*)(ws + WS_BBAR); float* POW = (float*)(ws + WS_POW); float* KTAB = (float*)(ws + WS_KTAB); float* SCTX = (float*)(ws + WS_SCTX); \
    bf16_t* W13T = (bf16_t*)(ws + WS_W13T); bf16_t* W2T = (bf16_t*)(ws + WS_W2T); bf16_t* WINT = (bf16_t*)(ws + WS_WINT); bf16_t* WUT = (bf16_t*)(ws + WS_WUT); \
    bf16_t* WOUTT = (bf16_t*)(ws + WS_WOUTT); bf16_t* S5INT = (bf16_t*)(ws + WS_S5INT); bf16_t* GLUT = (bf16_t*)(ws + WS_GLUT); \
    bf16_t* HCTX = (bf16_t*)(ws + WS_HCTX); bf16_t* Ab = (bf16_t*)(ws + WS_A); bf16_t* Yb = (bf16_t*)(ws + WS_Y); bf16_t* HB = (bf16_t*)(ws + WS_HB); \
    bf16_t* Ub = (bf16_t*)(ws + WS_U); bf16_t* PROJ = (bf16_t*)(ws + WS_PROJ); bf16_t* CN = (bf16_t*)(ws + WS_CN); bf16_t* QKV = (bf16_t*)(ws + WS_QKV); \
    bf16_t* XE = (bf16_t*)(ws + WS_XE); float* UC = (float*)(ws + WS_UC); float* Eb = (float*)(ws + WS_E); bf16_t* BMm = (bf16_t*)(ws + WS_BM); bf16_t* BSm = (bf16_t*)(ws + WS_BS); \
    float* OUT = gl(args.out); \
    const float* MOD0 = MOD; const float* MOD1 = MOD + 9 * 9216; (void)MOD0; (void)MOD1;

#define IN(i) gl(args.in[i])
#define GSYNC() do { for (int rs_ = 0; rs_ < PROBE_SYNC; ++rs_) { GAS unsigned char* wb_ = (GAS unsigned char*)args.ws; asm volatile("" : "+s"(wb_)); XcdBarrier xb_; xb_.bar = (unsigned*)(unsigned char*)wb_; xb_.x = xb_xcc_id(); xb_.st = (volatile LAS unsigned*)(lds + XB_LDS_OFF); xcd_barrier(xb_); } } while (0)
#define TIDS int tid = threadIdx.x; asm volatile("" : "+v"(tid)); const int lane = tid & 63, wave = __builtin_amdgcn_readfirstlane(tid >> 6); const int gw = bx * 8 + wave, gt = bx * 512 + tid; (void)lane; (void)gw; (void)gt;

DI void prologue_phase(const Args& args, LAS unsigned char* lds) {
    KSETUP
    TIDS
    {
        LAS float* sS = (LAS float*)lds;
        LAS float* sR = (LAS float*)(lds + 36864);
        for (int i = tid; i < 9 * 1024; i += 512) { const int r = i >> 10, k = i & 1023; const float c = r < 8 ? IN(I_C)[r * 1024 + k] : IN(I_CCTX)[k]; sS[i] = c * sigm(c); }
        __syncthreads();
        for (int u = bx; u < 288; u += G) {
            const int l = u / 144, n = (u % 144) * 64 + lane; const float* W = IN(I_MODW) + (size_t)l * 1024 * 9216 + n;
            float acc[9];
#pragma unroll
            for (int r = 0; r < 9; ++r) acc[r] = 0.f;
#pragma unroll 4
            for (int k = wave * 128; k < wave * 128 + 128; ++k) { const float w = W[(size_t)k * 9216];
#pragma unroll
                for (int r = 0; r < 9; ++r) acc[r] += sS[r * 1024 + k] * w; }
#pragma unroll
            for (int r = 0; r < 9; ++r) sR[(wave * 9 + r) * 64 + lane] = acc[r];
            __syncthreads();
            for (int i = tid; i < 9 * 64; i += 512) { const int r = i >> 6, c = i & 63; float s = 0.f;
#pragma unroll
                for (int w = 0; w < 8; ++w) s += sR[(w * 9 + r) * 64 + c];
                const int nn = (u % 144) * 64 + c; MOD[((size_t)l * 9 + r) * 9216 + nn] = s + IN(I_MODB)[l * 9216 + nn]; }
            __syncthreads();
        }
        LAS float* scr = (LAS float*)(lds + wave * 16384);
        constexpr int I13 = 16 * 176, I2 = 44 * 32, IIN = 16 * 37, IUQ = 4 * 24, IUKV = 2 * 32, ISQ = 16 * 32, IGLU = 16 * 64;
        constexpr int NIT = 4 * I13 + 4 * I2 + IIN + IUQ + IUKV + ISQ + ISQ + IGLU;
        for (int it = gw; it < NIT; it += ngw) {
            int r = it;
            if (r < 4 * I13) { const int w = r / I13; r %= I13; const int kb = r / 176, nb = r % 176; transpose_item(IN(I_W13) + (size_t)w * 1024 * 5632, 5632, W13T + (size_t)w * 5632 * 1024, 1024, 0, pairmap(nb * 32, 2816), scr, kb * 64, nb * 32, lane); continue; } r -= 4 * I13;
            if (r < 4 * I2) { const int w = r / I2; r %= I2; const int kb = r / 32, nb = r % 32; transpose_item(IN(I_W2) + (size_t)w * 2816 * 1024, 1024, W2T + (size_t)w * 1024 * 2816, 2816, 0, nb * 32, scr, kb * 64, nb * 32, lane); continue; } r -= 4 * I2;
            if (r < IIN) { const int kb = r / 37, nb = r % 37; transpose_item(IN(I_AWIN), 1184, WINT, 1024, 0, nb * 32, scr, kb * 64, nb * 32, lane); continue; } r -= IIN;
            if (r < IUQ) { const int kb = r / 24, nb = r % 24; transpose_item(IN(I_WUQ), 768, WUT, 384, 0, nb * 32, scr, kb * 64, nb * 32, lane); continue; } r -= IUQ;
            if (r < IUKV) { const int kb = r / 32, nb = r % 32; transpose_item(IN(I_WUKV), 1024, WUT, 384, 256, 768 + nb * 32, scr, kb * 64, nb * 32, lane); continue; } r -= IUKV;
            if (r < ISQ) { const int kb = r / 32, nb = r % 32; transpose_item(IN(I_AWOUT), 1024, WOUTT, 1024, 0, nb * 32, scr, kb * 64, nb * 32, lane); continue; } r -= ISQ;
            if (r < ISQ) { const int kb = r / 32, nb = r % 32; transpose_item(IN(I_S5WIN), 1024, S5INT, 1024, 0, nb * 32, scr, kb * 64, nb * 32, lane); continue; } r -= ISQ;
            { const int kb = r / 64, nb = r % 64; transpose_item(IN(I_WGLU), 2048, GLUT, 1024, 0, pairmap(nb * 32, 1024), scr, kb * 64, nb * 32, lane); }
        }
        const u32x4 z4 = (u32x4){0u, 0u, 0u, 0u};
        for (int i = gt; i < 96 * 128; i += ngt) *(u32x4*)(WINT + (size_t)(1184 + i / 128) * 1024 + (i % 128) * 8) = z4;
        for (int i = gt; i < 768 * 16; i += ngt) *(u32x4*)(WUT + (size_t)(i / 16) * 384 + 256 + (i % 16) * 8) = z4;
        for (int i = gt; i < 1024 * 32; i += ngt) *(u32x4*)(WUT + (size_t)(768 + i / 32) * 384 + (i % 32) * 8) = z4;
        for (int i = gt; i < 128 * 24; i += ngt) { const int p = i / 24, f = i % 24;
            if (f < 8) { const float inv = exp2f(-13.287712379549449f * (2.f * f / 16.f)); float s, c; sincos_rad_d((double)((float)p * inv), s, c); ROPE[p * 8 + f] = c; ROPE[1024 + p * 8 + f] = s; }
            else { const int ff = f - 8; const float inv = exp2f(-13.287712379549449f * (2.f * ff / 32.f)); float s, c; sincos_rad_d((double)((float)p * inv), s, c); ROPE[2048 + p * 16 + ff] = c; ROPE[4096 + p * 16 + ff] = s; } }
        for (int i = gt; i < 2 * 64 * 64; i += ngt) { const int dir = i >> 12, g = (i >> 6) & 63, p = i & 63;
            const float lre = fminf(IN(I_LRE)[i], -1e-4f), lim = IN(I_LIM)[i], dt = __expf(IN(I_LSTEP)[dir * 64 + g]);
            float* pw = POW + (size_t)i * 130;
            for (int d = 0; d <= 64; ++d) { const float mag = __expf(lre * dt * (float)d); float s, c; sincos_rad_d((double)lim * (double)dt * (double)d, s, c); pw[2 * d] = mag * c; pw[2 * d + 1] = mag * s; }
            const float are = pw[2], aim = pw[3]; ABAR[2 * i] = are; ABAR[2 * i + 1] = aim;
            const float den = lre * lre + lim * lim, fre = ((are - 1.f) * lre + aim * lim) / den, fim = (aim * lre - (are - 1.f) * lim) / den;
            for (int hh = 0; hh < 16; ++hh) { const float br = IN(I_BRE)[(size_t)i * 16 + hh], bi = IN(I_BIM)[(size_t)i * 16 + hh]; BBAR[((size_t)i * 16 + hh) * 2] = fre * br - fim * bi; BBAR[((size_t)i * 16 + hh) * 2 + 1] = fre * bi + fim * br; } }
    }

}
#define RUN_GEMM(EPI_T, epi, Aptr, Btptr, M_, N_, K_, lda_, ldb_, mtg_, strB_) do { pg8::Gemm g_{(Aptr), (Btptr), (M_), (N_), (K_), (lda_), (ldb_), (mtg_), (size_t)(strB_)}; pg8::StaticOrder S_; S_.init((M_), (N_), G, bx); \
        pg8::gemm_phase<EPI_T>(lds, g_, S_, (epi)); } while (0)
    constexpr int NOGRP = 1 << 30;


template <int l>
DI void layer_phase(const Args& args, LAS unsigned char* lds, cg::grid_group& grid) {
    KSETUP

        const float* MODL = l == 0 ? MOD0 : MOD1;
        const float* npre = IN(I_NPRE) + l * 3 * D; const float* npost = IN(I_NPOST) + l * 3 * D;
        if (l == 0) {
            TIDS
            for (int rep_ = 0; rep_ < PROBE_MISC; ++rep_) for (int i = gt; i < 64 * 2 * 64 * 16; i += ngt) { const int hh = i & 15, d = (i >> 4) & 63, dir = (i >> 10) & 1, g = i >> 11; const int base = (dir * 64 + g) * 64;
                const float* cr = IN(I_CRE) + ((size_t)(dir * 64 + g) * 16 + hh) * 64; const float* ci = IN(I_CIM) + ((size_t)(dir * 64 + g) * 16 + hh) * 64; float acc[16];
#pragma unroll
                for (int q = 0; q < 16; ++q) acc[q] = 0.f;
#pragma unroll 4
                for (int p = 0; p < 64; ++p) { const float pr = POW[(size_t)(base + p) * 130 + 2 * d], pi = POW[(size_t)(base + p) * 130 + 2 * d + 1]; const float c_r = cr[p], c_i = ci[p];
                    const float al = c_r * pr - c_i * pi, be = c_r * pi + c_i * pr; const f32x4* bb = (const f32x4*)(BBAR + (size_t)(base + p) * 32);
#pragma unroll
                    for (int q = 0; q < 8; ++q) { const f32x4 v = bb[q]; acc[2 * q] += v.x * al - v.y * be; acc[2 * q + 1] += v.z * al - v.w * be; } }
                f32x4* o = (f32x4*)(KTAB + ((((size_t)g * 2 + dir) * 64 + d) * 16 + hh) * 16);
#pragma unroll
                for (int q = 0; q < 4; ++q) o[q] = (f32x4){acc[4 * q], acc[4 * q + 1], acc[4 * q + 2], acc[4 * q + 3]}; }
            RowOp o{IN(I_X), IN(I_CTX), false, nullptr, nullptr, true, nullptr, nullptr, nullptr, 0, 0.f, npre, MODL, 0, 1, Ab, TA};
            row_phase(o, gw, ngw, lane);
            GSYNC();
        }
        for (int rep_ = 0; rep_ < PROBE_G1; ++rep_) { pg8::EpiSwiglu e{Ub}; RUN_GEMM(pg8::EpiSwiglu, e, Ab, W13T + (size_t)(l * 2) * 5632 * 1024, TA, 5632, 1024, 1024, 1024, NOGRP, 0); }
        GSYNC();
        for (int rep_ = 0; rep_ < PROBE_G2; ++rep_) { pg8::EpiBf16 e{Yb, D}; RUN_GEMM(pg8::EpiBf16, e, Ub, W2T + (size_t)(l * 2) * 1024 * 2816, TA, 1024, 2816, 2816, 2816, NOGRP, 0); }
        GSYNC();
        {
            TIDS
            RowOp o{l == 0 ? (const void*)IN(I_X) : (const void*)HB, l == 0 ? (const void*)IN(I_CTX) : (const void*)HCTX, l != 0, HB, HCTX, true, Yb, npost, MODL, 2, 0.5f, npre + D, MODL, 3, 4, Ab, TA};
            row_phase(o, gw, ngw, lane);
        }
        GSYNC();
        if (l == 0) {
            { pg8::EpiBf16 e{PROJ, PROJ_N}; RUN_GEMM(pg8::EpiBf16, e, Ab, WINT, TA, PROJ_N, 1024, 1024, 1024, NOGRP, 0); }
            GSYNC();
            { TIDS
            for (int row0 = gw; row0 < TA; row0 += 2 * ngw) {
                u32x2 wq[2]; unsigned wk[2]; float ka[2], kb[2], sa[2], sb[2]; bool ok[2];
#pragma unroll
                for (int u = 0; u < 2; ++u) { const int row = row0 + u * ngw; ok[u] = row < TA; ka[u] = kb[u] = sa[u] = sb[u] = 0.f; wq[u] = (u32x2){0u, 0u}; wk[u] = 0u;
                    if (ok[u]) { const bf16_t* pr = PROJ + (size_t)row * PROJ_N; wq[u] = ((const u32x2*)pr)[lane]; wk[u] = ((const unsigned*)(pr + 256))[lane];
                        if (row < TL) { if (lane < 16) { ka[u] = bf2f(pr[384 + lane]); kb[u] = bf2f(pr[400 + lane]); }
                            const bf16_t* q = pr + 928 + (lane >> 5) * 64; sa[u] = bf2f(q[lane & 31]); sb[u] = bf2f(q[32 + (lane & 31)]); } } }
#pragma unroll
                for (int u = 0; u < 2; ++u) if (ok[u]) { const int row = row0 + u * ngw; bf16_t* pr = PROJ + (size_t)row * PROJ_N;
                    { const u32x2 w = wq[u]; float v0 = bf2f(w.x & 0xffff), v1 = bf2f(w.x >> 16), v2 = bf2f(w.y & 0xffff), v3 = bf2f(w.y >> 16);
                      const float rstd = 1.0f / sqrtf(wave_sum(v0 * v0 + v1 * v1 + v2 * v2 + v3 * v3) * (1.f / 256.f) + EPSV); const f32x4 g = ((const f32x4*)IN(I_QNORM))[lane];
                      u32x2 o; o.x = cvtpk(v0 * rstd * g.x, v1 * rstd * g.y); o.y = cvtpk(v2 * rstd * g.z, v3 * rstd * g.w); ((u32x2*)(CN + (size_t)row * CN_N))[lane] = o; }
                    { const unsigned w = wk[u]; float v0 = bf2f(w & 0xffff), v1 = bf2f(w >> 16);
                      const float rstd = 1.0f / sqrtf(wave_sum(v0 * v0 + v1 * v1) * (1.f / 128.f) + EPSV); const float g0 = IN(I_KVNORM)[2 * lane], g1 = IN(I_KVNORM)[2 * lane + 1];
                      ((unsigned*)(CN + (size_t)row * CN_N + 256))[lane] = cvtpk(v0 * rstd * g0, v1 * rstd * g1); }
                    if (row < TL) { const int pos = row & 8191, rr = pos >> 6, cc = pos & 63;
                        if (lane < 16) { const int i = lane, p = i < 8 ? rr : cc, f = i & 7; const float c = ROPE[p * 8 + f], sn = ROPE[1024 + p * 8 + f]; const float a_ = ka[u], b_ = kb[u];
                            pr[384 + i] = (bf16_t)f2bf(a_ * c - b_ * sn); pr[400 + i] = (bf16_t)f2bf(a_ * sn + b_ * c); }
                        { const int hd = lane >> 5, i = lane & 31, p = i < 16 ? rr : cc, f = i & 15; const float c = ROPE[2048 + p * 16 + f], sn = ROPE[4096 + p * 16 + f]; bf16_t* q = pr + 928 + hd * 64;
                            const float a_ = sa[u], b_ = sb[u]; q[i] = (bf16_t)f2bf(a_ * c - b_ * sn); q[32 + i] = (bf16_t)f2bf(a_ * sn + b_ * c); } } }
            } }
            GSYNC();
            {
                pg8::EpiBf16 eq{QKV, QKV_N}; RUN_GEMM(pg8::EpiBf16, eq, CN, WUT, TA, 768, 256, CN_N, CN_N, NOGRP, 0);
                pg8::EpiBf16 ek{QKV + 768, QKV_N}; RUN_GEMM(pg8::EpiBf16, ek, CN + 256, WUT + (size_t)768 * CN_N + 256, TA, 1024, 128, CN_N, CN_N, NOGRP, 0); }
            GSYNC();
            {
                const float scA = 0.10206207261596577f * LOG2E, scB = 0.125f * LOG2E;
                for (int rep_ = 0; rep_ < PROBE_ATT; ++rep_) {
                for (int u = vcu; u < 2048; u += G) { const int bh = u >> 5, qb = u & 31, b = bh >> 3, hd = bh & 7; const size_t lrow = (size_t)b * SEQ, crow_ = (size_t)TL + b * CTXN;
                    attn_unit<96>(lds, QKV + (lrow + qb * 256) * QKV_N + hd * 96, QKV_N, QKV + crow_ * QKV_N + 768 + hd * 128, QKV + lrow * QKV_N + 768 + hd * 128, QKV_N,
                                  PROJ + crow_ * PROJ_N + 384, PROJ + lrow * PROJ_N + 384, PROJ_N, QKV + crow_ * QKV_N + 832 + hd * 128, QKV + lrow * QKV_N + 832 + hd * 128, QKV_N,
                                  Ab + (lrow + qb * 256) * D + hd * 64, D, 0, 128, false, qb * 256, scA, false, 0.f, 1, ROPE); }
                for (int u = vcu; u < 2048; u += G) { const int bh = u >> 5, qb = u & 31, b = bh >> 3, qh = bh & 7; const size_t lrow = (size_t)b * SEQ, crow_ = (size_t)TL + b * CTXN;
                    const int lo = (4 * qb - 2) < 0 ? 0 : 4 * qb - 2, hi = (4 * qb + 6) > 128 ? 128 : 4 * qb + 6;
                    attn_unit<64>(lds, PROJ + (lrow + qb * 256) * PROJ_N + 416 + qh * 64, PROJ_N, PROJ + crow_ * PROJ_N + 928 + (qh >> 2) * 64, PROJ + lrow * PROJ_N + 928 + (qh >> 2) * 64, PROJ_N,
                                  nullptr, nullptr, 0, PROJ + crow_ * PROJ_N + 1056 + (qh >> 2) * 64, PROJ + lrow * PROJ_N + 1056 + (qh >> 2) * 64, PROJ_N,
                                  Ab + (lrow + qb * 256) * D + 512 + qh * 64, D, lo, hi, true, qb * 256, scB, true, IN(I_SINK)[qh] * LOG2E, 2, ROPE); }
                for (int u = vcu; u < 64; u += G) { const int b = u >> 3, hd = u & 7; const size_t crow_ = (size_t)TL + b * CTXN;
                    attn_unit<96>(lds, QKV + crow_ * QKV_N + hd * 96, QKV_N, QKV + crow_ * QKV_N + 768 + hd * 128, QKV, QKV_N, PROJ + crow_ * PROJ_N + 384, PROJ, PROJ_N,
                                  QKV + crow_ * QKV_N + 832 + hd * 128, QKV, QKV_N, Ab + crow_ * D + hd * 64, D, 0, 0, false, 0, scA, false, 0.f, 0, ROPE);
                    attn_unit<64>(lds, PROJ + crow_ * PROJ_N + 416 + hd * 64, PROJ_N, PROJ + crow_ * PROJ_N + 928 + (hd >> 2) * 64, PROJ, PROJ_N, nullptr, nullptr, 0,
                                  PROJ + crow_ * PROJ_N + 1056 + (hd >> 2) * 64, PROJ, PROJ_N, Ab + crow_ * D + 512 + hd * 64, D, 0, 0, false, 0, scB, true, IN(I_SINK)[hd] * LOG2E, 0, ROPE); }
                }
            }
            GSYNC();
            { pg8::EpiBf16 e{Yb, D}; RUN_GEMM(pg8::EpiBf16, e, Ab, WOUTT, TA, 1024, 1024, 1024, 1024, NOGRP, 0); }
            GSYNC();
        } else {
            { TIDS
            const float* cre = IN(I_CRE); const float* cim = IN(I_CIM); const float* dsk = IN(I_S5D);
            for (int rep_ = 0; rep_ < PROBE_MISC; ++rep_) for (int i0 = gt; i0 < 64 * 1024 * 128; i0 += 4 * ngt) {
                f32x4 a0[4], a1[4], b0[4], b1[4]; float dg[4];
#pragma unroll
                for (int u = 0; u < 4; ++u) { const int i = i0 + u * ngt; if (i < 64 * 1024 * 128) { const int k8 = (i & 127) * 8, n = (i >> 7) & 1023, g = i >> 17, tp = n >> 4, hh = n & 15, sp = k8 >> 4, h0 = k8 & 15, dd = tp - sp, dA = dd > 0 ? dd : 0, dB = dd < 0 ? -dd : 0;
                    const f32x4* ka = (const f32x4*)(KTAB + ((((size_t)g * 2 + 0) * 64 + dA) * 16 + hh) * 16 + h0); const f32x4* kb = (const f32x4*)(KTAB + ((((size_t)g * 2 + 1) * 64 + dB) * 16 + hh) * 16 + h0);
                    a0[u] = ka[0]; a1[u] = ka[1]; b0[u] = kb[0]; b1[u] = kb[1]; dg[u] = (dd == 0) ? dsk[g * 16 + hh] : 0.f; } }
#pragma unroll
                for (int u = 0; u < 4; ++u) { const int i = i0 + u * ngt; if (i < 64 * 1024 * 128) { const int k8 = (i & 127) * 8, n = (i >> 7) & 1023, g = i >> 17, tp = n >> 4, hh = n & 15, sp = k8 >> 4, h0 = k8 & 15, dd = tp - sp; const float wa = dd >= 0 ? 1.f : 0.f, wb = dd <= 0 ? 1.f : 0.f; float v[8];
#pragma unroll
                    for (int j = 0; j < 4; ++j) { v[j] = wa * a0[u][j] + wb * b0[u][j] + ((h0 + j) == hh ? dg[u] : 0.f); v[4 + j] = wa * a1[u][j] + wb * b1[u][j] + ((h0 + 4 + j) == hh ? dg[u] : 0.f); }
                    u32x4 w; w.x = cvtpk(v[0], v[1]); w.y = cvtpk(v[2], v[3]); w.z = cvtpk(v[4], v[5]); w.w = cvtpk(v[6], v[7]); *(u32x4*)(BMm + ((size_t)g * 1024 + n) * XE_K + k8) = w; } } }
            for (int rep_ = 0; rep_ < PROBE_MISC; ++rep_) for (int i = gt; i < 64 * 1024 * 32; i += ngt) { const int kk = (i & 31) * 8, n = (i >> 5) & 1023, g = i >> 15, tp = n >> 4, hh = n & 15, dir = kk >> 7, ri = (kk >> 6) & 1, p0 = kk & 63, e = dir == 0 ? tp + 1 : 64 - tp; float v[8];
#pragma unroll
                for (int j = 0; j < 8; ++j) { const int p = p0 + j; const float pr = POW[(size_t)((dir * 64 + g) * 64 + p) * 130 + 2 * e], pi = POW[(size_t)((dir * 64 + g) * 64 + p) * 130 + 2 * e + 1];
                    const float cr = cre[((size_t)(dir * 64 + g) * 16 + hh) * 64 + p], ci = cim[((size_t)(dir * 64 + g) * 16 + hh) * 64 + p]; v[j] = ri == 0 ? cr * pr - ci * pi : -(cr * pi + ci * pr); }
                u32x4 w; w.x = cvtpk(v[0], v[1]); w.y = cvtpk(v[2], v[3]); w.z = cvtpk(v[4], v[5]); w.w = cvtpk(v[6], v[7]); *(u32x4*)(BMm + ((size_t)g * 1024 + n) * XE_K + 1024 + kk) = w; }
            for (int rep_ = 0; rep_ < PROBE_MISC; ++rep_) for (int i = gt; i < 64 * 256 * 128; i += ngt) { const int k8 = (i & 127) * 8, n = (i >> 7) & 255, g = i >> 15, dir = n >> 7, ri = (n >> 6) & 1, p = n & 63, sp = k8 >> 4, h0 = k8 & 15, e = dir == 0 ? 63 - sp : sp;
                const size_t ib = (size_t)((dir * 64 + g) * 64 + p); const float pr = POW[ib * 130 + 2 * e], pi = POW[ib * 130 + 2 * e + 1]; float v[8];
#pragma unroll
                for (int j = 0; j < 8; ++j) { const float br = BBAR[(ib * 16 + h0 + j) * 2], bi = BBAR[(ib * 16 + h0 + j) * 2 + 1]; v[j] = ri == 0 ? pr * br - pi * bi : pr * bi + pi * br; }
                u32x4 w; w.x = cvtpk(v[0], v[1]); w.y = cvtpk(v[2], v[3]); w.z = cvtpk(v[4], v[5]); w.w = cvtpk(v[6], v[7]); *(u32x4*)(BSm + ((size_t)g * 256 + n) * 1024 + k8) = w; }
            }
            { pg8::EpiS5In e{XE, UC}; RUN_GEMM(pg8::EpiS5In, e, Ab, S5INT, TA, 1024, 1024, 1024, 1024, NOGRP, 0); }
            GSYNC();
            { TIDS
            LAS float* su = (LAS float*)lds;
            for (int rep_ = 0; rep_ < PROBE_MISC; ++rep_) for (int pi0 = bx * 2; pi0 < 512; pi0 += G * 2) {
                __syncthreads();
#pragma unroll
                for (int k = 0; k < 4; ++k) { const int idx = tid + 512 * k, pr = idx >> 10, rem = idx & 1023, j = rem >> 2, q = rem & 3, pi = pi0 + pr;
                    if (pi < 512) ((LAS f32x4*)su)[idx] = *(const f32x4*)(UC + (size_t)((pi >> 6) * 256 + j) * D + (pi & 63) * 16 + 4 * q); }
                __syncthreads();
                if (wave < 4 && pi0 + (wave >> 1) < 512) { const int pi = pi0 + (wave >> 1), dir = wave & 1, b = pi >> 6, g = pi & 63, p = lane; const size_t ib = (size_t)((dir * 64 + g) * 64 + p);
                    const float are = ABAR[2 * ib], aim = ABAR[2 * ib + 1]; float br[16], bi[16];
#pragma unroll
                    for (int hh = 0; hh < 16; ++hh) { br[hh] = BBAR[(ib * 16 + hh) * 2]; bi[hh] = BBAR[(ib * 16 + hh) * 2 + 1]; }
                    float sr = 0.f, si = 0.f; const LAS f32x4* ub = (const LAS f32x4*)su + (wave >> 1) * 1024;
#pragma unroll 4
                    for (int jj = 0; jj < 256; ++jj) { const int j = dir == 0 ? jj : 255 - jj; const LAS f32x4* up = ub + j * 4; float ur = 0.f, ui = 0.f;
#pragma unroll
                        for (int q = 0; q < 4; ++q) { const f32x4 uv = up[q]; ur += uv.x * br[4 * q] + uv.y * br[4 * q + 1] + uv.z * br[4 * q + 2] + uv.w * br[4 * q + 3]; ui += uv.x * bi[4 * q] + uv.y * bi[4 * q + 1] + uv.z * bi[4 * q + 2] + uv.w * bi[4 * q + 3]; }
                        const float nr = are * sr - aim * si + ur, ni = are * si + aim * sr + ui; sr = nr; si = ni; }
                    SCTX[(((size_t)b * 64 + g) * 2 + dir) * 128 + p] = sr; SCTX[(((size_t)b * 64 + g) * 2 + dir) * 128 + 64 + p] = si; }
            }
            __syncthreads();
            }
            { pg8::EpiF32 e{Eb, 256}; RUN_GEMM(pg8::EpiF32, e, XE, BSm, 64 * 1024, 256, 1024, XE_K, 1024, 4, 256 * 1024); }
            GSYNC();
            { TIDS
            for (int rep_ = 0; rep_ < PROBE_MISC; ++rep_) for (int i = gt; i < 8 * 64 * 2 * 64; i += ngt) { const int p = i & 63, dir = (i >> 6) & 1, g = (i >> 7) & 63, b = i >> 13; const size_t ib = (size_t)((dir * 64 + g) * 64 + p);
                const float are = POW[ib * 130 + 128], aim = POW[ib * 130 + 129];
                float sr = SCTX[(((size_t)b * 64 + g) * 2 + dir) * 128 + p], si = SCTX[(((size_t)b * 64 + g) * 2 + dir) * 128 + 64 + p];
                for (int cb = 0; cb < 128; cb += 8) { float er[8], ei[8];
#pragma unroll
                    for (int u = 0; u < 8; ++u) { const int c = dir == 0 ? cb + u : 127 - (cb + u); const size_t row = (size_t)g * 1024 + b * 128 + c; er[u] = Eb[row * 256 + dir * 128 + p]; ei[u] = Eb[row * 256 + dir * 128 + 64 + p]; }
#pragma unroll
                    for (int u = 0; u < 8; ++u) { const int c = dir == 0 ? cb + u : 127 - (cb + u); const size_t row = (size_t)g * 1024 + b * 128 + c;
                        XE[row * XE_K + 1024 + dir * 128 + p] = (bf16_t)f2bf(sr); XE[row * XE_K + 1024 + dir * 128 + 64 + p] = (bf16_t)f2bf(si);
                        const float nr = are * sr - aim * si + er[u], ni = are * si + aim * sr + ei[u]; sr = nr; si = ni; } } }
            }
            GSYNC();
            { pg8::EpiS5Out e{Ab}; RUN_GEMM(pg8::EpiS5Out, e, XE, BMm, 64 * 1024, 1024, XE_K, XE_K, XE_K, 4, 1024 * XE_K); }
            GSYNC();
            { pg8::EpiGlu e{Yb}; RUN_GEMM(pg8::EpiGlu, e, Ab, GLUT, TL, 2048, 1024, 1024, 1024, NOGRP, 0); }
            GSYNC();
        }
        const int nr2 = l == 0 ? TA : TL;
        {
            TIDS
            RowOp o{HB, HCTX, true, HB, HCTX, true, Yb, npost + D, MODL, 5, 1.0f, npre + 2 * D, MODL, 6, 7, Ab, nr2};
            row_phase(o, gw, ngw, lane);
        }
        GSYNC();
        for (int rep_ = 0; rep_ < PROBE_G1; ++rep_) { pg8::EpiSwiglu e{Ub}; RUN_GEMM(pg8::EpiSwiglu, e, Ab, W13T + (size_t)(l * 2 + 1) * 5632 * 1024, nr2, 5632, 1024, 1024, 1024, NOGRP, 0); }
        GSYNC();
        for (int rep_ = 0; rep_ < PROBE_G2; ++rep_) { pg8::EpiBf16 e{Yb, D}; RUN_GEMM(pg8::EpiBf16, e, Ub, W2T + (size_t)(l * 2 + 1) * 1024 * 2816, nr2, 1024, 2816, 2816, 2816, NOGRP, 0); }
        GSYNC();
        {
            TIDS
            RowOp o{HB, HCTX, true, l == 0 ? (void*)HB : (void*)OUT, HCTX, l == 0, Yb, npost + 2 * D, MODL, 8, 0.5f, l == 0 ? IN(I_NPRE) + 3 * D : nullptr, MOD1, 0, 1, Ab, nr2};
            row_phase(o, gw, ngw, lane);
        }
        if (l == 0) GSYNC();
}

__global__ void __launch_bounds__(512, 2) fwd_megakernel(Args args) {
    extern __shared__ __attribute__((aligned(16))) unsigned char lds_raw[];
    LAS unsigned char* lds = (LAS unsigned char*)lds_raw;
    cg::grid_group grid = cg::this_grid();
    {
        if (threadIdx.x < 2) ((LAS unsigned*)(lds + XB_LDS_OFF))[threadIdx.x] = 0u;
        if (blockIdx.x == 0) { GAS unsigned* bw = (GAS unsigned*)args.ws; for (int i = threadIdx.x; i < XCD_BAR_WORDS; i += 512) bw[i] = 0u; }
        __syncthreads();
    }
    for (int rep_ = 0; rep_ < PROBE_MISC * PROBE_PRO; ++rep_) { prologue_phase(args, lds); __syncthreads(); }
    grid.sync();
    if (threadIdx.x == 0) (void)xb_add((unsigned*)args.ws + XB_XCNT(xb_xcc_id()), 1u);
    layer_phase<0>(args, lds, grid);
    layer_phase<1>(args, lds, grid);
}

extern "C" void kernel_launch(void* const* d_in, const int* in_sizes, int n_in, void* d_out, int out_size, void* d_ws, size_t ws_size, hipStream_t stream) {
    static int grid_blocks = 0;
    if (grid_blocks == 0) {
        if (n_in != 27 || out_size != TL * D || ws_size < WS_END) { fprintf(stderr, "kernel_launch: unexpected shapes (n_in %d out %d ws %zu)\n", n_in, out_size, ws_size); grid_blocks = -1; return; }
        int dev = 0, cus = 0, per_cu = 0;
        hipGetDevice(&dev);
        hipDeviceGetAttribute(&cus, hipDeviceAttributeMultiprocessorCount, dev);
        hipFuncSetAttribute((const void*)fwd_megakernel, hipFuncAttributeMaxDynamicSharedMemorySize, LDS_BYTES);
        hipOccupancyMaxActiveBlocksPerMultiprocessor(&per_cu, (const void*)fwd_megakernel, 512, LDS_BYTES);
        if (per_cu < 1) per_cu = 1;
        grid_blocks = cus * per_cu;
        (void)hipGetLastError();
    }
    if (grid_blocks < 0) return;
    Args a{};
    for (int i = 0; i < 27; ++i) a.in[i] = (const float*)d_in[i];
    a.out = (float*)d_out; a.ws = (unsigned char*)d_ws;
    void* kargs[] = {&a};
    hipError_t e = hipLaunchCooperativeKernel((const void*)fwd_megakernel, dim3(grid_blocks), dim3(512), kargs, LDS_BYTES, stream);
    if (e != hipSuccess) fprintf(stderr, "cooperative launch failed: %s (grid %d)\n", hipGetErrorString(e), grid_blocks);
}
```

```cpp
#include <hip/hip_runtime.h>
#include <hip/hip_cooperative_groups.h>
#include <cstdio>
#include <cstdint>
namespace cg = cooperative_groups;

#define LAS __attribute__((address_space(3)))
#define DI __device__ __forceinline__
typedef unsigned short bf16_t;
typedef short bf16x8 __attribute__((ext_vector_type(8)));
typedef short s16x4 __attribute__((ext_vector_type(4)));
typedef float f32x4 __attribute__((ext_vector_type(4)));
typedef float f32x16 __attribute__((ext_vector_type(16)));
typedef unsigned u32x4 __attribute__((ext_vector_type(4)));
typedef unsigned u32x2 __attribute__((ext_vector_type(2)));
typedef float f32x2_t __attribute__((ext_vector_type(2)));
typedef __bf16 bf16x2_t __attribute__((ext_vector_type(2)));

constexpr int D = 1024, FF = 2816, TL = 65536, TC = 2048, TA = TL + TC, SEQ = 8192, CTXN = 256, NBATCH = 8;
constexpr int PROJ_N = 1280, CN_N = 384, QKV_N = 1792, XE_K = 1280;
constexpr float EPSV = 1e-6f;
constexpr float LOG2E = 1.4426950408889634f;
constexpr size_t MiB = (size_t)1 << 20;
constexpr size_t WS_MOD = 1 * MiB, WS_ROPE = 2 * MiB, WS_ABAR = 3 * MiB, WS_BBAR = 4 * MiB, WS_POW = 5 * MiB, WS_KTAB = 10 * MiB, WS_SCTX = 18 * MiB;
constexpr size_t WS_W13T = 20 * MiB, WS_W2T = 64 * MiB, WS_WINT = 86 * MiB, WS_WUT = 89 * MiB, WS_WOUTT = 91 * MiB, WS_S5INT = 93 * MiB, WS_GLUT = 95 * MiB;
constexpr size_t WS_HCTX = 100 * MiB, WS_A = 108 * MiB, WS_Y = 240 * MiB, WS_SCR = 504 * MiB;
constexpr size_t WS_U = WS_SCR;
constexpr size_t WS_PROJ = WS_SCR, WS_CN = WS_SCR + 166 * MiB, WS_QKV = WS_SCR + 216 * MiB;
constexpr size_t WS_XE = WS_SCR, WS_UC = WS_SCR + 160 * MiB, WS_E = WS_SCR + 168 * MiB, WS_BM = WS_SCR + 232 * MiB, WS_BS = WS_SCR + 392 * MiB;
constexpr size_t WS_END = 1024 * MiB;
static_assert(WS_U + (size_t)TA * FF * 2 <= WS_END, "U");
static_assert(WS_PROJ + (size_t)TA * PROJ_N * 2 <= WS_CN && WS_CN + (size_t)TA * CN_N * 2 <= WS_QKV && WS_QKV + (size_t)TA * QKV_N * 2 <= WS_END, "attn scratch");
static_assert(WS_BS + (size_t)64 * 256 * 1024 * 2 <= WS_END && WS_BM + (size_t)64 * 1024 * XE_K * 2 <= WS_BS, "s5 scratch");
constexpr size_t WS_HB = 372 * MiB;
static_assert(WS_A + (size_t)TA * D * 2 <= WS_Y && WS_Y + (size_t)TA * D * 2 <= WS_HB && WS_HB + (size_t)TL * D * 2 <= WS_SCR, "A/Y/HB");
#ifndef PROBE_ATT
#define PROBE_ATT 1
#endif
#ifndef PROBE_PRO
#define PROBE_PRO 1
#endif
#ifndef PROBE_MISC
#define PROBE_MISC 1
#endif
#ifndef PROBE_SYNC
#define PROBE_SYNC 1
#endif
#ifndef PROBE_G1
#define PROBE_G1 1
#endif
#ifndef PROBE_G2
#define PROBE_G2 1
#endif
constexpr int LDS_BYTES = 147456;

#define GAS __attribute__((address_space(1)))
template <class T> DI T* gl(T* p) { return (T*)(GAS T*)p; }
DI unsigned f2bf(float f) { unsigned u = __builtin_bit_cast(unsigned, f); return (u + 0x7fffu + ((u >> 16) & 1u)) >> 16; }
DI unsigned cvtpk(float lo, float hi) { f32x2_t v = {lo, hi}; bf16x2_t b = __builtin_convertvector(v, bf16x2_t); return __builtin_bit_cast(unsigned, b); }
DI float bf2f(unsigned short b) { return __builtin_bit_cast(float, (unsigned)b << 16); }
DI float wave_sum(float v) {
    v += __builtin_bit_cast(float, __builtin_amdgcn_update_dpp(0, __builtin_bit_cast(int, v), 0xB1, 0xf, 0xf, true));
    v += __builtin_bit_cast(float, __builtin_amdgcn_update_dpp(0, __builtin_bit_cast(int, v), 0x4E, 0xf, 0xf, true));
    v += __builtin_bit_cast(float, __builtin_amdgcn_update_dpp(0, __builtin_bit_cast(int, v), 0x141, 0xf, 0xf, true));
    v += __builtin_bit_cast(float, __builtin_amdgcn_update_dpp(0, __builtin_bit_cast(int, v), 0x140, 0xf, 0xf, true));
    { auto rr = __builtin_amdgcn_permlane16_swap(__float_as_uint(v), __float_as_uint(v), false, false); v = __uint_as_float(rr[0]) + __uint_as_float(rr[1]); }
    { auto rr = __builtin_amdgcn_permlane32_swap(__float_as_uint(v), __float_as_uint(v), false, false); v = __uint_as_float(rr[0]) + __uint_as_float(rr[1]); }
    return v;
}
DI float sigm(float x) { return __builtin_amdgcn_rcpf(1.f + __expf(-x)); }
DI void sincos_rad_d(double ang, float& s, float& c) { double rev = ang * 0.15915494309189535; rev -= __builtin_rint(rev); const float f = (float)rev; s = __builtin_amdgcn_sinf(f); c = __builtin_amdgcn_cosf(f); }

namespace pg8 {
constexpr int BM = 256, BK = 64, HALF = 128, HTB = HALF * BK * 2, STAGE_BYTES = 8 * HTB, NXCD = 8, WGM = 8;
DI int lds_byte(int r, int c) { const int st = (r >> 4) * 2 + (c >> 5), rr = r & 15, cc = c & 31, ob = rr * 64 + cc * 2; return st * 1024 + (ob ^ (((ob >> 9) & 1) << 5)); }
DI void stage_rc(int b, int& R, int& C) { const int st = b / 1024, sb = b % 1024, swz = sb ^ (((sb >> 9) & 1) << 5); R = (st >> 1) * 16 + swz / 64; C = (st & 1) * 32 + (swz % 64) / 2; }
DI int perm32(int rho) { const int n = rho >> 4, i = rho & 15; return 8 * (i >> 2) + 4 * n + (i & 3); }
struct Unit { int pm, pn; };
struct Gemm { const bf16_t* A; const bf16_t* Bt; int M, N, K, lda, ldb, mt_per_group; size_t strideB; };
struct StaticOrder {
    int nM, nN, nwg, G, c;
    DI void init(int M, int N, int G_, int c_) { nM = M / BM; nN = N / BM; nwg = nM * nN; G = G_; c = c_; }
    DI bool next(int i, Unit& u) const {
        const long L = (long)i * G + c; if (L >= nwg) return false;
        int wgid = (int)L; { const int q = nwg / NXCD, r = nwg % NXCD, xcd = wgid % NXCD, off = wgid / NXCD; wgid = (xcd < r ? xcd * (q + 1) : r * (q + 1) + (xcd - r) * q) + off; }
        const int nig = WGM * nN, gid = wgid / nig, fm = gid * WGM, gsz = (nM - fm) < WGM ? (nM - fm) : WGM;
        u.pm = fm + ((wgid % nig) % gsz); u.pn = (wgid % nig) / gsz; return true;
    }
};
template <class Epi>
DI void gemm_phase(LAS unsigned char* lds, const Gemm g, const StaticOrder& S, const Epi& E) {
    int tid_ = threadIdx.x; asm volatile("" : "+v"(tid_));
    const int tid = tid_, wid = __builtin_amdgcn_readfirstlane(tid >> 6), lane = tid & 63, wr = wid >> 2, wc = wid & 3, fr = lane & 15, fq = lane >> 4;
    const int K = g.K, nt = K / BK;
    unsigned voffA[2], voffB[2];
#pragma unroll
    for (int i = 0; i < 2; ++i) { int R, C; stage_rc(tid * 16 + i * 8192, R, C); const int Rb = Epi::PERM ? ((R & ~31) + perm32(R & 31)) : R;
        voffA[i] = (unsigned)(R * g.lda + C) * 2u; voffB[i] = (unsigned)(Rb * g.ldb + C) * 2u; }
    const size_t kstep = (size_t)(BK * 2);
    const size_t hstepA = (size_t)HALF * g.lda * 2, hstepB = (size_t)HALF * g.ldb * 2, tstepA = 2 * hstepA, tstepB = 2 * hstepB;
    const unsigned ldsw = (unsigned)wid * 1024u;
    const int aoff = lds_byte(wr * 64 + fr, fq * 8), boff = lds_byte(wc * 32 + fr, fq * 8);
#define PG8_SA(b, h) (((b) * 2 + (h)) * HTB)
#define PG8_SB(b, h) ((4 + (b) * 2 + (h)) * HTB)
#define PG8_STAGE(bufoff, gbase, voff) do { _Pragma("unroll") for (int _i = 0; _i < 2; ++_i) \
        __builtin_amdgcn_global_load_lds((const unsigned*)((const char*)(gbase) + (voff)[_i]), (LAS unsigned*)(lds + (bufoff) + ldsw + _i * 8192), 16, 0, 0); } while (0)
#define PG8_LDA(dst, b, h) do { _Pragma("unroll") for (int m = 0; m < 4; ++m) _Pragma("unroll") for (int k = 0; k < 2; ++k) dst[m][k] = *(const LAS bf16x8*)(lds + PG8_SA(b, h) + aoff + m * 2048 + k * 1024); } while (0)
#define PG8_LDB(dst, b, h) do { _Pragma("unroll") for (int n = 0; n < 2; ++n) _Pragma("unroll") for (int k = 0; k < 2; ++k) dst[n][k] = *(const LAS bf16x8*)(lds + PG8_SB(b, h) + boff + n * 2048 + k * 1024); } while (0)
#define PG8_MMA(ai, bj, At, Bt) do { __builtin_amdgcn_s_setprio(1); _Pragma("unroll") for (int m = 0; m < 4; ++m) _Pragma("unroll") for (int n = 0; n < 2; ++n) _Pragma("unroll") for (int k = 0; k < 2; ++k) \
        acc[ai][bj][m][n] = __builtin_amdgcn_mfma_f32_16x16x32_bf16(Bt[n][k], At[m][k], acc[ai][bj][m][n], 0, 0, 0); __builtin_amdgcn_s_setprio(0); } while (0)
#define PG8_WAIT_V(n) asm volatile("s_waitcnt vmcnt(" #n ")" ::: "memory")
#define PG8_WAIT_L(n) asm volatile("s_waitcnt lgkmcnt(" #n ")" ::: "memory")
#define PG8_BAR __builtin_amdgcn_s_barrier()
#define PG8_SCHED __builtin_amdgcn_sched_barrier(0)
#define PG8_BPTR(u) ((const char*)g.Bt + (size_t)((u).pm / g.mt_per_group) * g.strideB * 2 + (size_t)(u).pn * tstepB)
    Unit cur, nxt; int ui = 0;
    if (!S.next(0, cur)) return;
    f32x4 acc[2][2][4][2];
#pragma unroll
    for (int a = 0; a < 2; ++a)
#pragma unroll
        for (int b = 0; b < 2; ++b)
#pragma unroll
            for (int m = 0; m < 4; ++m)
#pragma unroll
                for (int n = 0; n < 2; ++n) acc[a][b][m][n] = (f32x4){0.f, 0.f, 0.f, 0.f};
    bf16x8 At[4][2], B0[2][2], B1[2][2];
    const char* cA = (const char*)g.A + (size_t)cur.pm * tstepA; const char* cB = PG8_BPTR(cur);
    PG8_STAGE(PG8_SB(0, 0), cB, voffB); PG8_STAGE(PG8_SB(0, 1), cB + hstepB, voffB); PG8_STAGE(PG8_SA(0, 0), cA, voffA); PG8_STAGE(PG8_SA(0, 1), cA + hstepA, voffA);
    if (wr == 1) PG8_BAR;
    PG8_WAIT_V(2); PG8_BAR;
    PG8_STAGE(PG8_SB(1, 0), cB + kstep, voffB); PG8_STAGE(PG8_SA(1, 0), cA + kstep, voffA); PG8_STAGE(PG8_SB(1, 1), cB + hstepB + kstep, voffB);
    PG8_WAIT_V(6); PG8_BAR;
    for (;;) {
        const bool has_next = S.next(ui + 1, nxt);
        const char* nA = has_next ? (const char*)g.A + (size_t)nxt.pm * tstepA : cA; const char* nB = has_next ? PG8_BPTR(nxt) : cB;
        for (int t = 0; t < nt; t += 2) {
            const bool last = (t == nt - 2);
            const char* a1 = cA + (size_t)(t + 1) * kstep;
            const char* a2 = last ? nA : cA + (size_t)(t + 2) * kstep; const char* b2 = last ? nB : cB + (size_t)(t + 2) * kstep;
            const char* a3 = a2 + kstep; const char* b3 = b2 + kstep;
            PG8_LDB(B0, 0, 0); PG8_LDB(B1, 0, 1); PG8_SCHED; PG8_LDA(At, 0, 0); PG8_STAGE(PG8_SA(1, 1), a1 + hstepA, voffA);
            PG8_WAIT_V(8); PG8_WAIT_L(0); PG8_BAR; PG8_MMA(0, 0, At, B0); PG8_MMA(0, 1, At, B1); PG8_BAR; PG8_SCHED;
            PG8_LDA(At, 0, 1); PG8_STAGE(PG8_SB(0, 0), b2, voffB); PG8_STAGE(PG8_SB(0, 1), b2 + hstepB, voffB); PG8_STAGE(PG8_SA(0, 0), a2, voffA);
            PG8_WAIT_V(8); PG8_WAIT_L(0); PG8_BAR; PG8_MMA(1, 0, At, B0); PG8_MMA(1, 1, At, B1); PG8_BAR; PG8_SCHED;
            PG8_LDB(B0, 1, 0); PG8_LDB(B1, 1, 1); PG8_SCHED; PG8_LDA(At, 1, 0); PG8_STAGE(PG8_SA(0, 1), a2 + hstepA, voffA);
            PG8_WAIT_V(8); PG8_WAIT_L(0); PG8_BAR; PG8_MMA(0, 0, At, B0); PG8_MMA(0, 1, At, B1); PG8_BAR; PG8_SCHED;
            PG8_LDA(At, 1, 1); PG8_STAGE(PG8_SB(1, 0), b3, voffB); PG8_STAGE(PG8_SB(1, 1), b3 + hstepB, voffB); PG8_STAGE(PG8_SA(1, 0), a3, voffA);
            PG8_WAIT_V(8); PG8_WAIT_L(0); PG8_BAR; PG8_MMA(1, 0, At, B0); PG8_MMA(1, 1, At, B1); PG8_BAR; PG8_SCHED;
        }
        if (wr == 0) PG8_BAR;
        { int t2_ = threadIdx.x; asm volatile("" : "+v"(t2_)); const int w2_ = t2_ >> 6, l2_ = t2_ & 63; E(acc, cur, w2_ >> 2, w2_ & 3, l2_ & 15, l2_ >> 4); }
        if (!has_next) break;
#pragma unroll
        for (int a = 0; a < 2; ++a)
#pragma unroll
            for (int b = 0; b < 2; ++b)
#pragma unroll
                for (int m = 0; m < 4; ++m)
#pragma unroll
                    for (int n = 0; n < 2; ++n) acc[a][b][m][n] = (f32x4){0.f, 0.f, 0.f, 0.f};
        cur = nxt; cA = nA; cB = nB; ++ui;
        if (wr == 1) PG8_BAR;
    }
    PG8_WAIT_V(0);
    PG8_BAR;
#undef PG8_SA
#undef PG8_SB
#undef PG8_STAGE
#undef PG8_LDA
#undef PG8_LDB
#undef PG8_MMA
#undef PG8_WAIT_V
#undef PG8_WAIT_L
#undef PG8_BAR
#undef PG8_SCHED
#undef PG8_BPTR
}
typedef f32x4 Acc[2][2][4][2];
DI u32x4 pack8(const f32x4 v0, const f32x4 v1) { u32x4 w; w.x = cvtpk(v0[0], v0[1]); w.y = cvtpk(v0[2], v0[3]); w.z = cvtpk(v1[0], v1[1]); w.w = cvtpk(v1[2], v1[3]); return w; }
struct EpiBf16 {
    static constexpr bool PERM = true; bf16_t* O; int ldc;
    DI void operator()(const Acc& acc, const Unit& u, int wr, int wc, int fr, int fq) const {
        const int row0 = u.pm * BM + wr * 64 + fr, col0 = u.pn * BM + wc * 32 + 8 * fq;
#pragma unroll
        for (int ai = 0; ai < 2; ++ai)
#pragma unroll
            for (int m = 0; m < 4; ++m) { bf16_t* rowp = O + (size_t)(row0 + ai * HALF + m * 16) * ldc + col0;
#pragma unroll
                for (int bj = 0; bj < 2; ++bj) *(u32x4*)(rowp + bj * HALF) = pack8(acc[ai][bj][m][0], acc[ai][bj][m][1]); }
    }
};
struct EpiSwiglu {
    static constexpr bool PERM = true; bf16_t* O;
    DI void operator()(const Acc& acc, const Unit& u, int wr, int wc, int fr, int fq) const {
        const int row0 = u.pm * BM + wr * 64 + fr, col0 = u.pn * HALF + wc * 32 + 8 * fq;
#pragma unroll
        for (int ai = 0; ai < 2; ++ai)
#pragma unroll
            for (int m = 0; m < 4; ++m) { f32x4 r0, r1;
#pragma unroll
                for (int j = 0; j < 4; ++j) { const float g0 = acc[ai][0][m][0][j], g1 = acc[ai][0][m][1][j]; r0[j] = g0 * sigm(g0) * acc[ai][1][m][0][j]; r1[j] = g1 * sigm(g1) * acc[ai][1][m][1][j]; }
                *(u32x4*)(O + (size_t)(row0 + ai * HALF + m * 16) * FF + col0) = pack8(r0, r1); }
    }
};
struct EpiF32 {
    static constexpr bool PERM = false; float* O; int ldc;
    DI void operator()(const Acc& acc, const Unit& u, int wr, int wc, int fr, int fq) const {
        const int row0 = u.pm * BM + wr * 64 + fr, col0 = u.pn * BM + wc * 32 + 4 * fq;
#pragma unroll
        for (int ai = 0; ai < 2; ++ai)
#pragma unroll
            for (int m = 0; m < 4; ++m) { float* rowp = O + (size_t)(row0 + ai * HALF + m * 16) * ldc + col0;
#pragma unroll
                for (int bj = 0; bj < 2; ++bj)
#pragma unroll
                    for (int n = 0; n < 2; ++n) *(f32x4*)(rowp + bj * HALF + n * 16) = acc[ai][bj][m][n]; }
    }
};
struct EpiGlu {
    static constexpr bool PERM = true; bf16_t* O;
    DI void operator()(const Acc& acc, const Unit& u, int wr, int wc, int fr, int fq) const {
        const int row0 = u.pm * BM + wr * 64 + fr, col0 = u.pn * HALF + wc * 32 + 8 * fq;
#pragma unroll
        for (int ai = 0; ai < 2; ++ai)
#pragma unroll
            for (int m = 0; m < 4; ++m) { f32x4 r0, r1;
#pragma unroll
                for (int j = 0; j < 4; ++j) { r0[j] = acc[ai][0][m][0][j] * sigm(acc[ai][1][m][0][j]); r1[j] = acc[ai][0][m][1][j] * sigm(acc[ai][1][m][1][j]); }
                *(u32x4*)(O + (size_t)(row0 + ai * HALF + m * 16) * D + col0) = pack8(r0, r1); }
    }
};
struct EpiS5In {
    static constexpr bool PERM = true; bf16_t* XE; float* UC;
    DI void operator()(const Acc& acc, const Unit& u, int wr, int wc, int fr, int fq) const {
        const int row0 = u.pm * BM + wr * 64 + fr, col0 = u.pn * BM + wc * 32 + 8 * fq;
#pragma unroll
        for (int ai = 0; ai < 2; ++ai)
#pragma unroll
            for (int m = 0; m < 4; ++m) { const int row = row0 + ai * HALF + m * 16;
#pragma unroll
                for (int bj = 0; bj < 2; ++bj) { const int c8 = col0 + bj * HALF;
                    if (row < TL) { const int b = row >> 13, s = row & 8191, gi = c8 >> 4;
                        *(u32x4*)(XE + ((size_t)(gi * 1024 + b * 128 + (s >> 6)) * XE_K + (s & 63) * 16 + (c8 & 15))) = pack8(acc[ai][bj][m][0], acc[ai][bj][m][1]); }
                    else { float* p = UC + (size_t)(row - TL) * D + c8; *(f32x4*)p = acc[ai][bj][m][0]; *(f32x4*)(p + 4) = acc[ai][bj][m][1]; } } }
    }
};
struct EpiS5Out {
    static constexpr bool PERM = true; bf16_t* YG;
    DI void operator()(const Acc& acc, const Unit& u, int wr, int wc, int fr, int fq) const {
        const int row0 = u.pm * BM + wr * 64 + fr, col0 = u.pn * BM + wc * 32 + 8 * fq;
#pragma unroll
        for (int ai = 0; ai < 2; ++ai)
#pragma unroll
            for (int m = 0; m < 4; ++m) { const int rf = row0 + ai * HALF + m * 16, gi = rf >> 10, r = rf & 1023, b = r >> 7, c = r & 127;
#pragma unroll
                for (int bj = 0; bj < 2; ++bj) { const int n8 = col0 + bj * HALF, tp = n8 >> 4, ho = n8 & 15; f32x4 r0, r1;
#pragma unroll
                    for (int j = 0; j < 4; ++j) { const float y0 = acc[ai][bj][m][0][j], y1 = acc[ai][bj][m][1][j];
                        r0[j] = y0 * sigm(1.5957691216f * (y0 + 0.044715f * y0 * y0 * y0)); r1[j] = y1 * sigm(1.5957691216f * (y1 + 0.044715f * y1 * y1 * y1)); }
                    *(u32x4*)(YG + (size_t)(b * SEQ + c * 64 + tp) * D + gi * 16 + ho) = pack8(r0, r1); } }
    }
};
}

DI int crow(int i, int h) { return (i & 3) + 8 * (i >> 2) + 4 * h; }
DI bf16x8 rope_pair_lo(const bf16x8 x1, const bf16x8 x2, const float* cs, const float* sn, bf16x8& out2) {
    bf16x8 o1;
#pragma unroll
    for (int j = 0; j < 8; ++j) { const float a = bf2f((unsigned short)x1[j]), b = bf2f((unsigned short)x2[j]), c = cs[j], s = sn[j];
        o1[j] = (short)f2bf(a * c - b * s); out2[j] = (short)f2bf(a * s + b * c); }
    return o1;
}
template <int DQK>
DI void attn_unit(LAS unsigned char* lds, const bf16_t* Qrow0, int qpitch,
                  const bf16_t* KA_ctx, const bf16_t* KA_lat, int pA, const bf16_t* KB_ctx, const bf16_t* KB_lat, int pB,
                  const bf16_t* V_ctx, const bf16_t* V_lat, int pV, bf16_t* Orow0, int opitch,
                  int t_lo2, int t_hi2, bool band, int q0, float sc, bool has_sink, float sink_l2, int rope, const float* ropeT) {
    constexpr int NCH = DQK / 8, KP = DQK + 8, VP = 96, ND = DQK / 16;
    constexpr int KBUF = 64 * KP * 2, VBUF = 64 * VP * 2, VOFF = 2 * KBUF;
    int tid_ = threadIdx.x; asm volatile("" : "+v"(tid_));
    const int tid = tid_, lane = tid & 63, wid = __builtin_amdgcn_readfirstlane(tid >> 6), r = lane & 31, h = lane >> 5;
    bf16x8 qf[ND];
    { const bf16_t* qrow = Qrow0 + (size_t)(wid * 32 + r) * qpitch;
#pragma unroll
      for (int d0 = 0; d0 < ND; ++d0) qf[d0] = *(const bf16x8*)(qrow + 16 * d0 + 8 * h);
      if (rope) { const int pos = q0 + wid * 32 + r, rr = pos >> 6, cc = pos & 63;
        if (DQK == 96) { const float* cA = ropeT; const float* sA = ropeT + 1024; const int p = h ? cc : rr;
            bf16x8 o2; const bf16x8 o1 = rope_pair_lo(qf[ND - 2], qf[ND - 1], cA + p * 8, sA + p * 8, o2); qf[ND - 2] = o1; qf[ND - 1] = o2; }
        else { const float* cB = ropeT + 2048; const float* sB = ropeT + 4096;
            bf16x8 o2; bf16x8 o1 = rope_pair_lo(qf[0], qf[2], cB + rr * 16 + 8 * h, sB + rr * 16 + 8 * h, o2); qf[0] = o1; qf[2] = o2;
            o1 = rope_pair_lo(qf[1], qf[3], cB + cc * 16 + 8 * h, sB + cc * 16 + 8 * h, o2); qf[1] = o1; qf[3] = o2; } }
#pragma unroll
      for (int d0 = 0; d0 < ND; ++d0) { u32x4 w;
#pragma unroll
        for (int j = 0; j < 4; ++j) w[j] = cvtpk(bf2f((unsigned short)qf[d0][2 * j]) * sc, bf2f((unsigned short)qf[d0][2 * j + 1]) * sc);
        qf[d0] = __builtin_bit_cast(bf16x8, w); } }
    const int ntl = 4 + (t_hi2 - t_lo2);
    const bool k1v = (tid + 512) < 64 * NCH;
    const int grp = wid >> 2;
    u32x4 kr0, kr1 = (u32x4){0u, 0u, 0u, 0u}, vr;
#define AT_LOADK(t) do { const bool ic_ = (t) < 4; const int rb_ = ic_ ? (t) * 64 : (t_lo2 + (t) - 4) * 64; \
        { const int ch_ = tid, row_ = ch_ / NCH, c_ = ch_ % NCH; const bf16_t* s_ = (DQK == 64 || c_ < 8) ? (ic_ ? KA_ctx : KA_lat) + (size_t)(rb_ + row_) * pA + c_ * 8 : (ic_ ? KB_ctx : KB_lat) + (size_t)(rb_ + row_) * pB + (c_ - 8) * 8; kr0 = *(const u32x4*)s_; } \
        if (k1v) { const int ch_ = tid + 512, row_ = ch_ / NCH, c_ = ch_ % NCH; const bf16_t* s_ = (DQK == 64 || c_ < 8) ? (ic_ ? KA_ctx : KA_lat) + (size_t)(rb_ + row_) * pA + c_ * 8 : (ic_ ? KB_ctx : KB_lat) + (size_t)(rb_ + row_) * pB + (c_ - 8) * 8; kr1 = *(const u32x4*)s_; } } while (0)
#define AT_LOADV(t) do { const bool ic_ = (t) < 4; const int rb_ = ic_ ? (t) * 64 : (t_lo2 + (t) - 4) * 64; \
        { const int row_ = tid >> 3, c_ = tid & 7; vr = *(const u32x4*)((ic_ ? V_ctx : V_lat) + (size_t)(rb_ + row_) * pV + c_ * 8); } } while (0)
#define AT_STOREK(buf) do { { const int ch_ = tid, row_ = ch_ / NCH, c_ = ch_ % NCH; *(LAS u32x4*)(lds + (buf) * KBUF + (row_ * KP + c_ * 8) * 2) = kr0; } \
        if (k1v) { const int ch_ = tid + 512, row_ = ch_ / NCH, c_ = ch_ % NCH; *(LAS u32x4*)(lds + (buf) * KBUF + (row_ * KP + c_ * 8) * 2) = kr1; } } while (0)
#define AT_STOREV(buf) do { const int row_ = tid >> 3, c_ = tid & 7; *(LAS u32x4*)(lds + VOFF + (buf) * VBUF + (row_ * VP + c_ * 8) * 2) = vr; } while (0)
    float m_run = has_sink ? sink_l2 : 0.f, l_run = (has_sink && h == 0) ? 1.f : 0.f;
    bool started = false;
    f32x16 o0, o1, p0, p1, negm;
#pragma unroll
    for (int i = 0; i < 16; ++i) { o0[i] = 0.f; o1[i] = 0.f; p0[i] = 0.f; p1[i] = 0.f; negm[i] = -m_run; }
    bf16x8 pa[2][2];
#pragma unroll
    for (int a = 0; a < 2; ++a)
#pragma unroll
        for (int b = 0; b < 2; ++b) pa[a][b] = (bf16x8){0, 0, 0, 0, 0, 0, 0, 0};
    const int qw = q0 + wid * 32;
    const int vlane = (((lane & 15) >> 2) * VP + 16 * ((lane >> 4) & 1)) * 2 + 8 * (lane & 3) + (4 * h) * VP * 2;
    AT_LOADK(0); AT_STOREK(0);
    if (1 < ntl) AT_LOADK(1);
    AT_LOADV(0);
    __syncthreads();
    if (grp == 1) __syncthreads();
    bool act = false, act_prev = false; int kt0 = 0;
    for (int t = 0; t <= ntl; ++t) {
        if (t + 1 < ntl) AT_STOREK((t + 1) & 1);
        if (t < ntl) AT_STOREV(t & 1);
        if (t + 2 < ntl) AT_LOADK(t + 2);
        if (t + 1 < ntl) AT_LOADV(t + 1);
        if (t >= 1 && act_prev) {
            const LAS unsigned char* Vb = lds + VOFF + ((t - 1) & 1) * VBUF;
#pragma unroll
            for (int kb = 0; kb < 2; ++kb)
#pragma unroll
                for (int s = 0; s < 2; ++s) {
                    const LAS unsigned char* vb = Vb + vlane + (kb * 32 + 16 * s) * VP * 2;
#pragma unroll
                    for (int db = 0; db < 2; ++db) {
                        const s16x4 lo = __builtin_bit_cast(s16x4, __builtin_amdgcn_ds_read_tr16_b64_v4i16((LAS s16x4*)(vb + db * 64)));
                        const s16x4 hi = __builtin_bit_cast(s16x4, __builtin_amdgcn_ds_read_tr16_b64_v4i16((LAS s16x4*)(vb + db * 64 + 8 * VP * 2)));
                        const bf16x8 vf = __builtin_shufflevector(lo, hi, 0, 1, 2, 3, 4, 5, 6, 7);
                        if (db == 0) o0 = __builtin_amdgcn_mfma_f32_32x32x16_bf16(vf, pa[kb][s], o0, 0, 0, 0);
                        else o1 = __builtin_amdgcn_mfma_f32_32x32x16_bf16(vf, pa[kb][s], o1, 0, 0, 0);
                    }
                }
        }
        act = false;
        if (t < ntl) {
            act = true;
            if (band && t >= 4) { kt0 = (t_lo2 + t - 4) * 64; act = (kt0 + 63 >= qw - 128) && (kt0 <= qw + 31 + 128); }
            if (act) {
                const LAS unsigned char* Kb = lds + (t & 1) * KBUF;
#pragma unroll
                for (int d0 = 0; d0 < ND; ++d0) {
                    const bf16x8 k0 = *(const LAS bf16x8*)(Kb + (r * KP + 16 * d0 + 8 * h) * 2);
                    const bf16x8 k1 = *(const LAS bf16x8*)(Kb + ((32 + r) * KP + 16 * d0 + 8 * h) * 2);
                    if (d0 == 0) { p0 = __builtin_amdgcn_mfma_f32_32x32x16_bf16(k0, qf[d0], negm, 0, 0, 0); p1 = __builtin_amdgcn_mfma_f32_32x32x16_bf16(k1, qf[d0], negm, 0, 0, 0); }
                    else { p0 = __builtin_amdgcn_mfma_f32_32x32x16_bf16(k0, qf[d0], p0, 0, 0, 0); p1 = __builtin_amdgcn_mfma_f32_32x32x16_bf16(k1, qf[d0], p1, 0, 0, 0); }
                }
            }
        }
        __syncthreads();
        if (act) {
            if (band && t >= 4) { const int qpos = qw + r;
#pragma unroll
                for (int i = 0; i < 16; ++i) { const int kp = kt0 + crow(i, h); int d = qpos - kp; d = d < 0 ? -d : d; if (d > 128) p0[i] = -1e30f; int d2 = qpos - kp - 32; d2 = d2 < 0 ? -d2 : d2; if (d2 > 128) p1[i] = -1e30f; } }
            f32x16 e0, e1; unsigned um = 0u;
#pragma unroll
            for (int i = 0; i < 16; ++i) { e0[i] = __builtin_amdgcn_exp2f(p0[i]); e1[i] = __builtin_amdgcn_exp2f(p1[i]); const unsigned a = __float_as_uint(e0[i]), b = __float_as_uint(e1[i]); um = um > a ? um : a; um = um > b ? um : b; }
            { auto rr = __builtin_amdgcn_permlane32_swap(um, um, false, false); um = rr[0] > rr[1] ? rr[0] : rr[1]; }
            if (!started || __any(um > 0x43800000u)) {
                float mx = fmaxf(p0[0], p1[0]);
#pragma unroll
                for (int i = 1; i < 16; ++i) mx = fmaxf(mx, fmaxf(p0[i], p1[i]));
                { auto rr = __builtin_amdgcn_permlane32_swap(__float_as_uint(mx), __float_as_uint(mx), false, false); mx = fmaxf(__uint_as_float(rr[0]), __uint_as_float(rr[1])); }
                float alpha = 1.f;
                if (started || has_sink) { mx = fmaxf(mx, 0.f); alpha = __builtin_amdgcn_exp2f(-mx); }
                m_run += mx; l_run *= alpha;
#pragma unroll
                for (int i = 0; i < 16; ++i) { o0[i] *= alpha; o1[i] *= alpha; e0[i] = __builtin_amdgcn_exp2f(p0[i] - mx); e1[i] = __builtin_amdgcn_exp2f(p1[i] - mx); negm[i] = -m_run; }
                started = true;
            }
            float sum = 0.f;
#pragma unroll
            for (int i = 0; i < 16; ++i) { sum += e0[i] + e1[i]; p0[i] = e0[i]; p1[i] = e1[i]; }
            l_run += sum;
#pragma unroll
            for (int s = 0; s < 2; ++s) { u32x4 w; w.x = cvtpk(p0[8 * s], p0[8 * s + 1]); w.y = cvtpk(p0[8 * s + 2], p0[8 * s + 3]); w.z = cvtpk(p0[8 * s + 4], p0[8 * s + 5]); w.w = cvtpk(p0[8 * s + 6], p0[8 * s + 7]); pa[0][s] = __builtin_bit_cast(bf16x8, w);
                u32x4 w2; w2.x = cvtpk(p1[8 * s], p1[8 * s + 1]); w2.y = cvtpk(p1[8 * s + 2], p1[8 * s + 3]); w2.z = cvtpk(p1[8 * s + 4], p1[8 * s + 5]); w2.w = cvtpk(p1[8 * s + 6], p1[8 * s + 7]); pa[1][s] = __builtin_bit_cast(bf16x8, w2); }
        }
        act_prev = act;
        __syncthreads();
    }
    if (grp == 0) __syncthreads();
#undef AT_LOADK
#undef AT_LOADV
#undef AT_STOREK
#undef AT_STOREV
    float lt = l_run; { auto rr = __builtin_amdgcn_permlane32_swap(__float_as_uint(lt), __float_as_uint(lt), false, false); lt = __uint_as_float(rr[0]) + __uint_as_float(rr[1]); }
    const float inv = 1.f / lt;
    LAS unsigned char* stg = lds + 51200 + wid * 4608;
#pragma unroll
    for (int g = 0; g < 4; ++g) {
        u32x2 w; w.x = cvtpk(o0[4 * g] * inv, o0[4 * g + 1] * inv); w.y = cvtpk(o0[4 * g + 2] * inv, o0[4 * g + 3] * inv); *(LAS u32x2*)(stg + r * 144 + (8 * g + 4 * h) * 2) = w;
        u32x2 w2; w2.x = cvtpk(o1[4 * g] * inv, o1[4 * g + 1] * inv); w2.y = cvtpk(o1[4 * g + 2] * inv, o1[4 * g + 3] * inv); *(LAS u32x2*)(stg + r * 144 + (32 + 8 * g + 4 * h) * 2) = w2;
    }
    asm volatile("s_waitcnt lgkmcnt(0)" ::: "memory");
    bf16_t* ow = Orow0 + (size_t)(wid * 32) * opitch;
#pragma unroll
    for (int i = 0; i < 4; ++i) { const int c = i * 64 + lane, row = c >> 3, ch = c & 7;
        const u32x4 v = *(const LAS u32x4*)(stg + row * 144 + ch * 16); *(u32x4*)(ow + (size_t)row * opitch + ch * 8) = v; }
}


#define XB_TMO      128
#define XB_XCNT(j)  (256  + 64 * (j))
#define XB_XSUB(j)  (1280 + 64 * (j))
#define XB_XGEN(j)  (2304 + 64 * (j))
#define XB_TOP      3328
#define XB_TOPGEN   3392
#define XCD_BAR_WORDS 3456
#define XB_SPIN_CAP (1u << 18)
DI unsigned xb_ld(unsigned* p)              { return __hip_atomic_load(p, __ATOMIC_RELAXED, __HIP_MEMORY_SCOPE_AGENT); }
DI unsigned xb_add(unsigned* p, unsigned v) { return __hip_atomic_fetch_add(p, v, __ATOMIC_RELAXED, __HIP_MEMORY_SCOPE_AGENT); }
DI unsigned xb_xcc_id() { return (unsigned)__builtin_amdgcn_s_getreg((3 << 11) | 20) & 0xFu; }
#define XB_SPIN(cond, bar) do { unsigned _sp = 0; while (cond) { __builtin_amdgcn_s_sleep(1); \
    if ((++_sp & 255u) == 0u) { if (xb_ld(&(bar)[XB_TMO])) break; if (_sp > XB_SPIN_CAP) { atomicAdd(&(bar)[XB_TMO], 1u); break; } } } } while (0)
struct XcdBarrier { unsigned* bar; unsigned x; volatile LAS unsigned* st; };
DI void xcd_barrier_complete(unsigned* bar, unsigned x, unsigned& nloc, unsigned& nx) {
    const unsigned G = gridDim.x * gridDim.y * gridDim.z;
    unsigned sum, cnt, mine, sp = 0u;
    for (;;) {
        sum = 0u; cnt = 0u; mine = 0u;
#pragma unroll
        for (unsigned j = 0; j < 16; ++j) { const unsigned c = xb_ld(&bar[XB_XCNT(j)]); sum += c; cnt += (c > 0u) ? 1u : 0u; mine = (j == x) ? c : mine; }
        if (sum == G) break;
        __builtin_amdgcn_s_sleep(1);
        if ((++sp & 255u) == 0u) { if (xb_ld(&bar[XB_TMO])) break; if (sp > XB_SPIN_CAP) { atomicAdd(&bar[XB_TMO], 1u); break; } }
    }
    nloc = mine > 0u ? mine : 1u; nx = cnt > 0u ? cnt : 1u;
}
DI void xcd_barrier(const XcdBarrier& b) {
    asm volatile("s_waitcnt vmcnt(0)" ::: "memory");
    __syncthreads();
    if (threadIdx.x == 0) {
        unsigned* bar = b.bar;
        __builtin_amdgcn_s_waitcnt(0);
        unsigned nloc = b.st[0], nx = b.st[1];
        if (nloc == 0u) { xcd_barrier_complete(bar, b.x, nloc, nx); b.st[0] = nloc; b.st[1] = nx; }
        const unsigned old = xb_add(&bar[XB_XSUB(b.x)], 1u);
        const unsigned gen = old / nloc;
        if (old + 1u == (gen + 1u) * nloc) {
            __builtin_amdgcn_fence(__ATOMIC_RELEASE, "agent");
            asm volatile("s_waitcnt vmcnt(0)" ::: "memory");
            const unsigned og = xb_add(&bar[XB_TOP], 1u);
            const unsigned tg = og / nx;
            if (og + 1u == (tg + 1u) * nx) xb_add(&bar[XB_TOPGEN], 1u);
            else XB_SPIN(xb_ld(&bar[XB_TOPGEN]) == tg, bar);
            __builtin_amdgcn_fence(__ATOMIC_ACQUIRE, "agent");
            xb_add(&bar[XB_XGEN(b.x)], 1u);
            asm volatile("s_waitcnt vmcnt(0)" ::: "memory");
        } else {
            XB_SPIN(xb_ld(&bar[XB_XGEN(b.x)]) == gen, bar);
            __builtin_amdgcn_fence(__ATOMIC_ACQUIRE, "agent");
            asm volatile("s_waitcnt vmcnt(0)" ::: "memory");
        }
    }
    __syncthreads();
}
constexpr int XB_LDS_OFF = 131072 + 64;

struct Args { const float* in[27]; float* out; unsigned char* ws; };
enum { I_X = 0, I_C, I_CTX, I_CCTX, I_MODW, I_MODB, I_NPRE, I_NPOST, I_W13, I_W2, I_AWIN, I_QNORM, I_WUQ, I_KVNORM, I_WUKV, I_SINK, I_AWOUT, I_S5WIN, I_LRE, I_LIM, I_BRE, I_BIM, I_CRE, I_CIM, I_LSTEP, I_S5D, I_WGLU };

DI void transpose_item(const float* W, int N, bf16_t* WT, int ldk, int koff, int drow0, LAS float* scr, int k0, int n0, int lane) {
#pragma unroll 8
    for (int i = 0; i < 32; ++i) { const int kk = 2 * i + (lane >> 5); scr[kk * 33 + (lane & 31)] = W[(size_t)(k0 + kk) * N + n0 + (lane & 31)]; }
    asm volatile("s_waitcnt lgkmcnt(0)" ::: "memory");
    const int c = lane & 7;
#pragma unroll
    for (int j = 0; j < 4; ++j) { const int n = (lane >> 3) + 8 * j; const LAS float* s = scr + (8 * c) * 33 + n;
        u32x4 o; o.x = cvtpk(s[0 * 33], s[1 * 33]); o.y = cvtpk(s[2 * 33], s[3 * 33]); o.z = cvtpk(s[4 * 33], s[5 * 33]); o.w = cvtpk(s[6 * 33], s[7 * 33]);
        *(u32x4*)(WT + (size_t)(drow0 + n) * ldk + koff + k0 + 8 * c) = o; }
    asm volatile("s_waitcnt lgkmcnt(0)" ::: "memory");
}
DI int pairmap(int n0, int split) { const int jj = n0 < split ? n0 : n0 - split; return (jj >> 7) * 256 + (n0 < split ? 0 : 128) + (jj & 127); }

struct RowOp {
    const void* hin_lat; const void* hin_ctx; bool hin_bf16; void* hout_lat; void* hout_ctx; bool hout_bf16;
    const bf16_t* Y; const float* g_post; const float* modg; int gate_idx; float coef;
    const float* g_pre; const float* modp; int shift_idx, scale_idx; bf16_t* A; int nrows;
};
DI void unpack8(const u32x4 w, float* v) {
#pragma unroll
    for (int e = 0; e < 4; ++e) { v[2 * e] = __builtin_bit_cast(float, w[e] << 16); v[2 * e + 1] = __builtin_bit_cast(float, w[e] & 0xffff0000u); }
}
DI void ld16(const float* v, int lane, float* d) {
    const f32x4* p = (const f32x4*)v;
#pragma unroll
    for (int j = 0; j < 2; ++j)
#pragma unroll
        for (int q = 0; q < 2; ++q) { const f32x4 x = p[2 * lane + q + 128 * j];
#pragma unroll
            for (int e = 0; e < 4; ++e) d[8 * j + 4 * q + e] = x[e]; }
}
DI void row_phase(const RowOp& o, int gw, int ngw, int lane) {
    const int chunk = (o.nrows + ngw - 1) / ngw, rbeg = gw * chunk, rend = (rbeg + chunk) < o.nrows ? (rbeg + chunk) : o.nrows;
    float gpo[16], gpr[16], gat[16], shf[16], scl[16]; int cur = -1;
#pragma unroll
    for (int e = 0; e < 16; ++e) { gpo[e] = 0.f; gpr[e] = 0.f; gat[e] = 0.f; shf[e] = 0.f; scl[e] = 0.f; }
    if (o.Y) ld16(o.g_post, lane, gpo);
    if (o.g_pre) ld16(o.g_pre, lane, gpr);
    for (int row0 = rbeg; row0 < rend; row0 += 4) {
        float hv[4][16], yv[4][16]; bool ok[4]; int rows[4];
#pragma unroll
        for (int u = 0; u < 4; ++u) { const int row = row0 + u; rows[u] = row; ok[u] = row < rend;
            if (ok[u]) { const size_t roff = row < TL ? (size_t)row * D : (size_t)(row - TL) * D;
                if (o.hin_bf16) { const u32x4* hp = (const u32x4*)((const bf16_t*)(row < TL ? o.hin_lat : o.hin_ctx) + roff);
#pragma unroll
                    for (int j = 0; j < 2; ++j) unpack8(hp[lane + 64 * j], &hv[u][8 * j]); }
                else { const f32x4* hp = (const f32x4*)((const float*)(row < TL ? o.hin_lat : o.hin_ctx) + roff);
#pragma unroll
                    for (int j = 0; j < 2; ++j) { const f32x4 a = hp[2 * lane + 128 * j], b = hp[2 * lane + 1 + 128 * j];
#pragma unroll
                        for (int e = 0; e < 4; ++e) { hv[u][8 * j + e] = a[e]; hv[u][8 * j + 4 + e] = b[e]; } } }
                if (o.Y) { const u32x4* yp = (const u32x4*)(o.Y + (size_t)row * D);
#pragma unroll
                    for (int j = 0; j < 2; ++j) unpack8(yp[lane + 64 * j], &yv[u][8 * j]); } } }
#pragma unroll
        for (int u = 0; u < 4; ++u) if (ok[u]) { const int row = rows[u]; const int mrow = row < TL ? (row >> 13) : 8; const size_t roff = row < TL ? (size_t)row * D : (size_t)(row - TL) * D;
            if (mrow != cur) { cur = mrow;
                if (o.Y) { ld16(o.modg + (size_t)mrow * 9216 + o.gate_idx * D, lane, gat);
#pragma unroll
                    for (int e = 0; e < 16; ++e) gat[e] *= o.coef; }
                if (o.g_pre) { ld16(o.modp + (size_t)mrow * 9216 + o.shift_idx * D, lane, shf); ld16(o.modp + (size_t)mrow * 9216 + o.scale_idx * D, lane, scl);
#pragma unroll
                    for (int e = 0; e < 16; ++e) scl[e] += 1.0f; } }
            if (o.Y) {
                float ss = 0.f;
#pragma unroll
                for (int e = 0; e < 16; ++e) ss += yv[u][e] * yv[u][e];
                const float rstd = 1.0f / sqrtf(wave_sum(ss) * (1.f / D) + EPSV);
#pragma unroll
                for (int e = 0; e < 16; ++e) hv[u][e] += gat[e] * (yv[u][e] * rstd * gpo[e]);
                if (o.hout_bf16) { u32x4* op = (u32x4*)((bf16_t*)(row < TL ? o.hout_lat : o.hout_ctx) + roff);
#pragma unroll
                    for (int j = 0; j < 2; ++j) { u32x4 w;
#pragma unroll
                        for (int e = 0; e < 4; ++e) w[e] = cvtpk(hv[u][8 * j + 2 * e], hv[u][8 * j + 2 * e + 1]);
                        op[lane + 64 * j] = w; unpack8(w, &hv[u][8 * j]); } }
                else { f32x4* op = (f32x4*)((float*)(row < TL ? o.hout_lat : o.hout_ctx) + roff);
#pragma unroll
                    for (int j = 0; j < 2; ++j) { op[2 * lane + 128 * j] = (f32x4){hv[u][8 * j], hv[u][8 * j + 1], hv[u][8 * j + 2], hv[u][8 * j + 3]}; op[2 * lane + 1 + 128 * j] = (f32x4){hv[u][8 * j + 4], hv[u][8 * j + 5], hv[u][8 * j + 6], hv[u][8 * j + 7]}; } }
            }
            if (o.g_pre) {
                float ss = 0.f;
#pragma unroll
                for (int e = 0; e < 16; ++e) ss += hv[u][e] * hv[u][e];
                const float rstd = 1.0f / sqrtf(wave_sum(ss) * (1.f / D) + EPSV);
                u32x4* ap = (u32x4*)(o.A + (size_t)row * D);
#pragma unroll
                for (int j = 0; j < 2; ++j) { u32x4 w;
#pragma unroll
                    for (int e = 0; e < 4; ++e) w[e] = cvtpk((hv[u][8 * j + 2 * e] * rstd * gpr[8 * j + 2 * e]) * scl[8 * j + 2 * e] + shf[8 * j + 2 * e], (hv[u][8 * j + 2 * e + 1] * rstd * gpr[8 * j + 2 * e + 1]) * scl[8 * j + 2 * e + 1] + shf[8 * j + 2 * e + 1]);
                    ap[lane + 64 * j] = w; }
            }
        }
    }
}

#define KSETUP \
    const int G = gridDim.x, bx = blockIdx.x; \
    const int ngw = G * 8, ngt = G * 512; \
    const int vcu = (G % 8 == 0) ? (bx % 8) * (G / 8) + bx / 8 : bx; \
    GAS unsigned char* wsg_ = (GAS unsigned char*)args.ws; asm volatile("" : "+s"(wsg_)); unsigned char* ws = (unsigned char*)wsg_; \
    float* MOD = (float*)(ws + WS_MOD); float* ROPE = (float*)(ws + WS_ROPE); \
    float* ABAR = (float*)(ws + WS_ABAR); float* BBAR = (float*)(ws + WS_BBAR); float* POW = (float*)(ws + WS_POW); float* KTAB = (float*)(ws + WS_KTAB); float* SCTX = (float*)(ws + WS_SCTX); \
    bf16_t* W13T = (bf16_t*)(ws + WS_W13T); bf16_t* W2T = (bf16_t*)(ws + WS_W2T); bf16_t* WINT = (bf16_t*)(ws + WS_WINT); bf16_t* WUT = (bf16_t*)(ws + WS_WUT); \
    bf16_t* WOUTT = (bf16_t*)(ws + WS_WOUTT); bf16_t* S5INT = (bf16_t*)(ws + WS_S5INT); bf16_t* GLUT = (bf16_t*)(ws + WS_GLUT); \
    bf16_t* HCTX = (bf16_t*)(ws + WS_HCTX); bf16_t* Ab = (bf16_t*)(ws + WS_A); bf16_t* Yb = (bf16_t*)(ws + WS_Y); bf16_t* HB = (bf16_t*)(ws + WS_HB); \
    bf16_t* Ub = (bf16_t*)(ws + WS_U); bf16_t* PROJ = (bf16_t*)(ws + WS_PROJ); bf16_t* CN = (bf16_t*)(ws + WS_CN); bf16_t* QKV = (bf16_t*)(ws + WS_QKV); \
    bf16_t* XE = (bf16_t*)(ws + WS_XE); float* UC = (float*)(ws + WS_UC); float* Eb = (float*)(ws + WS_E); bf16_t* BMm = (bf16_t*)(ws + WS_BM); bf16_t* BSm = (bf16_t*)(ws + WS_BS); \
    float* OUT = gl(args.out); \
    const float* MOD0 = MOD; const float* MOD1 = MOD + 9 * 9216; (void)MOD0; (void)MOD1;

#define IN(i) gl(args.in[i])
#define GSYNC() do { for (int rs_ = 0; rs_ < PROBE_SYNC; ++rs_) { GAS unsigned char* wb_ = (GAS unsigned char*)args.ws; asm volatile("" : "+s"(wb_)); XcdBarrier xb_; xb_.bar = (unsigned*)(unsigned char*)wb_; xb_.x = xb_xcc_id(); xb_.st = (volatile LAS unsigned*)(lds + XB_LDS_OFF); xcd_barrier(xb_); } } while (0)
#define TIDS int tid = threadIdx.x; asm volatile("" : "+v"(tid)); const int lane = tid & 63, wave = __builtin_amdgcn_readfirstlane(tid >> 6); const int gw = bx * 8 + wave, gt = bx * 512 + tid; (void)lane; (void)gw; (void)gt;

DI void prologue_phase(const Args& args, LAS unsigned char* lds) {
    KSETUP
    TIDS
    {
        LAS float* sS = (LAS float*)lds;
        LAS float* sR = (LAS float*)(lds + 36864);
        for (int i = tid; i < 9 * 1024; i += 512) { const int r = i >> 10, k = i & 1023; const float c = r < 8 ? IN(I_C)[r * 1024 + k] : IN(I_CCTX)[k]; sS[i] = c * sigm(c); }
        __syncthreads();
        for (int u = bx; u < 288; u += G) {
            const int l = u / 144, n = (u % 144) * 64 + lane; const float* W = IN(I_MODW) + (size_t)l * 1024 * 9216 + n;
            float acc[9];
#pragma unroll
            for (int r = 0; r < 9; ++r) acc[r] = 0.f;
#pragma unroll 4
            for (int k = wave * 128; k < wave * 128 + 128; ++k) { const float w = W[(size_t)k * 9216];
#pragma unroll
                for (int r = 0; r < 9; ++r) acc[r] += sS[r * 1024 + k] * w; }
#pragma unroll
            for (int r = 0; r < 9; ++r) sR[(wave * 9 + r) * 64 + lane] = acc[r];
            __syncthreads();
            for (int i = tid; i < 9 * 64; i += 512) { const int r = i >> 6, c = i & 63; float s = 0.f;
#pragma unroll
                for (int w = 0; w < 8; ++w) s += sR[(w * 9 + r) * 64 + c];
                const int nn = (u % 144) * 64 + c; MOD[((size_t)l * 9 + r) * 9216 + nn] = s + IN(I_MODB)[l * 9216 + nn]; }
            __syncthreads();
        }
        LAS float* scr = (LAS float*)(lds + wave * 16384);
        constexpr int I13 = 16 * 176, I2 = 44 * 32, IIN = 16 * 37, IUQ = 4 * 24, IUKV = 2 * 32, ISQ = 16 * 32, IGLU = 16 * 64;
        constexpr int NIT = 4 * I13 + 4 * I2 + IIN + IUQ + IUKV + ISQ + ISQ + IGLU;
        for (int it = gw; it < NIT; it += ngw) {
            int r = it;
            if (r < 4 * I13) { const int w = r / I13; r %= I13; const int kb = r / 176, nb = r % 176; transpose_item(IN(I_W13) + (size_t)w * 1024 * 5632, 5632, W13T + (size_t)w * 5632 * 1024, 1024, 0, pairmap(nb * 32, 2816), scr, kb * 64, nb * 32, lane); continue; } r -= 4 * I13;
            if (r < 4 * I2) { const int w = r / I2; r %= I2; const int kb = r / 32, nb = r % 32; transpose_item(IN(I_W2) + (size_t)w * 2816 * 1024, 1024, W2T + (size_t)w * 1024 * 2816, 2816, 0, nb * 32, scr, kb * 64, nb * 32, lane); continue; } r -= 4 * I2;
            if (r < IIN) { const int kb = r / 37, nb = r % 37; transpose_item(IN(I_AWIN), 1184, WINT, 1024, 0, nb * 32, scr, kb * 64, nb * 32, lane); continue; } r -= IIN;
            if (r < IUQ) { const int kb = r / 24, nb = r % 24; transpose_item(IN(I_WUQ), 768, WUT, 384, 0, nb * 32, scr, kb * 64, nb * 32, lane); continue; } r -= IUQ;
            if (r < IUKV) { const int kb = r / 32, nb = r % 32; transpose_item(IN(I_WUKV), 1024, WUT, 384, 256, 768 + nb * 32, scr, kb * 64, nb * 32, lane); continue; } r -= IUKV;
            if (r < ISQ) { const int kb = r / 32, nb = r % 32; transpose_item(IN(I_AWOUT), 1024, WOUTT, 1024, 0, nb * 32, scr, kb * 64, nb * 32, lane); continue; } r -= ISQ;
            if (r < ISQ) { const int kb = r / 32, nb = r % 32; transpose_item(IN(I_S5WIN), 1024, S5INT, 1024, 0, nb * 32, scr, kb * 64, nb * 32, lane); continue; } r -= ISQ;
            { const int kb = r / 64, nb = r % 64; transpose_item(IN(I_WGLU), 2048, GLUT, 1024, 0, pairmap(nb * 32, 1024), scr, kb * 64, nb * 32, lane); }
        }
        const u32x4 z4 = (u32x4){0u, 0u, 0u, 0u};
        for (int i = gt; i < 96 * 128; i += ngt) *(u32x4*)(WINT + (size_t)(1184 + i / 128) * 1024 + (i % 128) * 8) = z4;
        for (int i = gt; i < 768 * 16; i += ngt) *(u32x4*)(WUT + (size_t)(i / 16) * 384 + 256 + (i % 16) * 8) = z4;
        for (int i = gt; i < 1024 * 32; i += ngt) *(u32x4*)(WUT + (size_t)(768 + i / 32) * 384 + (i % 32) * 8) = z4;
        for (int i = gt; i < 128 * 24; i += ngt) { const int p = i / 24, f = i % 24;
            if (f < 8) { const float inv = exp2f(-13.287712379549449f * (2.f * f / 16.f)); float s, c; sincos_rad_d((double)((float)p * inv), s, c); ROPE[p * 8 + f] = c; ROPE[1024 + p * 8 + f] = s; }
            else { const int ff = f - 8; const float inv = exp2f(-13.287712379549449f * (2.f * ff / 32.f)); float s, c; sincos_rad_d((double)((float)p * inv), s, c); ROPE[2048 + p * 16 + ff] = c; ROPE[4096 + p * 16 + ff] = s; } }
        for (int i = gt; i < 2 * 64 * 64; i += ngt) { const int dir = i >> 12, g = (i >> 6) & 63, p = i & 63;
            const float lre = fminf(IN(I_LRE)[i], -1e-4f), lim = IN(I_LIM)[i], dt = __expf(IN(I_LSTEP)[dir * 64 + g]);
            float* pw = POW + (size_t)i * 130;
            for (int d = 0; d <= 64; ++d) { const float mag = __expf(lre * dt * (float)d); float s, c; sincos_rad_d((double)lim * (double)dt * (double)d, s, c); pw[2 * d] = mag * c; pw[2 * d + 1] = mag * s; }
            const float are = pw[2], aim = pw[3]; ABAR[2 * i] = are; ABAR[2 * i + 1] = aim;
            const float den = lre * lre + lim * lim, fre = ((are - 1.f) * lre + aim * lim) / den, fim = (aim * lre - (are - 1.f) * lim) / den;
            for (int hh = 0; hh < 16; ++hh) { const float br = IN(I_BRE)[(size_t)i * 16 + hh], bi = IN(I_BIM)[(size_t)i * 16 + hh]; BBAR[((size_t)i * 16 + hh) * 2] = fre * br - fim * bi; BBAR[((size_t)i * 16 + hh) * 2 + 1] = fre * bi + fim * br; } }
    }

}
#define RUN_GEMM(EPI_T, epi, Aptr, Btptr, M_, N_, K_, lda_, ldb_, mtg_, strB_) do { pg8::Gemm g_{(Aptr), (Btptr), (M_), (N_), (K_), (lda_), (ldb_), (mtg_), (size_t)(strB_)}; pg8::StaticOrder S_; S_.init((M_), (N_), G, bx); \
        pg8::gemm_phase<EPI_T>(lds, g_, S_, (epi)); } while (0)
    constexpr int NOGRP = 1 << 30;


template <int l>
DI void layer_phase(const Args& args, LAS unsigned char* lds, cg::grid_group& grid) {
    KSETUP

        const float* MODL = l == 0 ? MOD0 : MOD1;
        const float* npre = IN(I_NPRE) + l * 3 * D; const float* npost = IN(I_NPOST) + l * 3 * D;
        if (l == 0) {
            TIDS
            for (int rep_ = 0; rep_ < PROBE_MISC; ++rep_) for (int i = gt; i < 64 * 2 * 64 * 16; i += ngt) { const int hh = i & 15, d = (i >> 4) & 63, dir = (i >> 10) & 1, g = i >> 11; const int base = (dir * 64 + g) * 64;
                const float* cr = IN(I_CRE) + ((size_t)(dir * 64 + g) * 16 + hh) * 64; const float* ci = IN(I_CIM) + ((size_t)(dir * 64 + g) * 16 + hh) * 64; float acc[16];
#pragma unroll
                for (int q = 0; q < 16; ++q) acc[q] = 0.f;
#pragma unroll 4
                for (int p = 0; p < 64; ++p) { const float pr = POW[(size_t)(base + p) * 130 + 2 * d], pi = POW[(size_t)(base + p) * 130 + 2 * d + 1]; const float c_r = cr[p], c_i = ci[p];
                    const float al = c_r * pr - c_i * pi, be = c_r * pi + c_i * pr; const f32x4* bb = (const f32x4*)(BBAR + (size_t)(base + p) * 32);
#pragma unroll
                    for (int q = 0; q < 8; ++q) { const f32x4 v = bb[q]; acc[2 * q] += v.x * al - v.y * be; acc[2 * q + 1] += v.z * al - v.w * be; } }
                f32x4* o = (f32x4*)(KTAB + ((((size_t)g * 2 + dir) * 64 + d) * 16 + hh) * 16);
#pragma unroll
                for (int q = 0; q < 4; ++q) o[q] = (f32x4){acc[4 * q], acc[4 * q + 1], acc[4 * q + 2], acc[4 * q + 3]}; }
            RowOp o{IN(I_X), IN(I_CTX), false, nullptr, nullptr, true, nullptr, nullptr, nullptr, 0, 0.f, npre, MODL, 0, 1, Ab, TA};
            row_phase(o, gw, ngw, lane);
            GSYNC();
        }
        for (int rep_ = 0; rep_ < PROBE_G1; ++rep_) { pg8::EpiSwiglu e{Ub}; RUN_GEMM(pg8::EpiSwiglu, e, Ab, W13T + (size_t)(l * 2) * 5632 * 1024, TA, 5632, 1024, 1024, 1024, NOGRP, 0); }
        GSYNC();
        for (int rep_ = 0; rep_ < PROBE_G2; ++rep_) { pg8::EpiBf16 e{Yb, D}; RUN_GEMM(pg8::EpiBf16, e, Ub, W2T + (size_t)(l * 2) * 1024 * 2816, TA, 1024, 2816, 2816, 2816, NOGRP, 0); }
        GSYNC();
        {
            TIDS
            RowOp o{l == 0 ? (const void*)IN(I_X) : (const void*)HB, l == 0 ? (const void*)IN(I_CTX) : (const void*)HCTX, l != 0, HB, HCTX, true, Yb, npost, MODL, 2, 0.5f, npre + D, MODL, 3, 4, Ab, TA};
            row_phase(o, gw, ngw, lane);
        }
        GSYNC();
        if (l == 0) {
            { pg8::EpiBf16 e{PROJ, PROJ_N}; RUN_GEMM(pg8::EpiBf16, e, Ab, WINT, TA, PROJ_N, 1024, 1024, 1024, NOGRP, 0); }
            GSYNC();
            { TIDS
            for (int row0 = gw; row0 < TA; row0 += 2 * ngw) {
                u32x2 wq[2]; unsigned wk[2]; float ka[2], kb[2], sa[2], sb[2]; bool ok[2];
#pragma unroll
                for (int u = 0; u < 2; ++u) { const int row = row0 + u * ngw; ok[u] = row < TA; ka[u] = kb[u] = sa[u] = sb[u] = 0.f; wq[u] = (u32x2){0u, 0u}; wk[u] = 0u;
                    if (ok[u]) { const bf16_t* pr = PROJ + (size_t)row * PROJ_N; wq[u] = ((const u32x2*)pr)[lane]; wk[u] = ((const unsigned*)(pr + 256))[lane];
                        if (row < TL) { if (lane < 16) { ka[u] = bf2f(pr[384 + lane]); kb[u] = bf2f(pr[400 + lane]); }
                            const bf16_t* q = pr + 928 + (lane >> 5) * 64; sa[u] = bf2f(q[lane & 31]); sb[u] = bf2f(q[32 + (lane & 31)]); } } }
#pragma unroll
                for (int u = 0; u < 2; ++u) if (ok[u]) { const int row = row0 + u * ngw; bf16_t* pr = PROJ + (size_t)row * PROJ_N;
                    { const u32x2 w = wq[u]; float v0 = bf2f(w.x & 0xffff), v1 = bf2f(w.x >> 16), v2 = bf2f(w.y & 0xffff), v3 = bf2f(w.y >> 16);
                      const float rstd = 1.0f / sqrtf(wave_sum(v0 * v0 + v1 * v1 + v2 * v2 + v3 * v3) * (1.f / 256.f) + EPSV); const f32x4 g = ((const f32x4*)IN(I_QNORM))[lane];
                      u32x2 o; o.x = cvtpk(v0 * rstd * g.x, v1 * rstd * g.y); o.y = cvtpk(v2 * rstd * g.z, v3 * rstd * g.w); ((u32x2*)(CN + (size_t)row * CN_N))[lane] = o; }
                    { const unsigned w = wk[u]; float v0 = bf2f(w & 0xffff), v1 = bf2f(w >> 16);
                      const float rstd = 1.0f / sqrtf(wave_sum(v0 * v0 + v1 * v1) * (1.f / 128.f) + EPSV); const float g0 = IN(I_KVNORM)[2 * lane], g1 = IN(I_KVNORM)[2 * lane + 1];
                      ((unsigned*)(CN + (size_t)row * CN_N + 256))[lane] = cvtpk(v0 * rstd * g0, v1 * rstd * g1); }
                    if (row < TL) { const int pos = row & 8191, rr = pos >> 6, cc = pos & 63;
                        if (lane < 16) { const int i = lane, p = i < 8 ? rr : cc, f = i & 7; const float c = ROPE[p * 8 + f], sn = ROPE[1024 + p * 8 + f]; const float a_ = ka[u], b_ = kb[u];
                            pr[384 + i] = (bf16_t)f2bf(a_ * c - b_ * sn); pr[400 + i] = (bf16_t)f2bf(a_ * sn + b_ * c); }
                        { const int hd = lane >> 5, i = lane & 31, p = i < 16 ? rr : cc, f = i & 15; const float c = ROPE[2048 + p * 16 + f], sn = ROPE[4096 + p * 16 + f]; bf16_t* q = pr + 928 + hd * 64;
                            const float a_ = sa[u], b_ = sb[u]; q[i] = (bf16_t)f2bf(a_ * c - b_ * sn); q[32 + i] = (bf16_t)f2bf(a_ * sn + b_ * c); } } }
            } }
            GSYNC();
            {
                pg8::EpiBf16 eq{QKV, QKV_N}; RUN_GEMM(pg8::EpiBf16, eq, CN, WUT, TA, 768, 256, CN_N, CN_N, NOGRP, 0);
                pg8::EpiBf16 ek{QKV + 768, QKV_N}; RUN_GEMM(pg8::EpiBf16, ek, CN + 256, WUT + (size_t)768 * CN_N + 256, TA, 1024, 128, CN_N, CN_N, NOGRP, 0); }
            GSYNC();
            {
                const float scA = 0.10206207261596577f * LOG2E, scB = 0.125f * LOG2E;
                for (int rep_ = 0; rep_ < PROBE_ATT; ++rep_) {
                for (int u = vcu; u < 2048; u += G) { const int bh = u >> 5, qb = u & 31, b = bh >> 3, hd = bh & 7; const size_t lrow = (size_t)b * SEQ, crow_ = (size_t)TL + b * CTXN;
                    attn_unit<96>(lds, QKV + (lrow + qb * 256) * QKV_N + hd * 96, QKV_N, QKV + crow_ * QKV_N + 768 + hd * 128, QKV + lrow * QKV_N + 768 + hd * 128, QKV_N,
                                  PROJ + crow_ * PROJ_N + 384, PROJ + lrow * PROJ_N + 384, PROJ_N, QKV + crow_ * QKV_N + 832 + hd * 128, QKV + lrow * QKV_N + 832 + hd * 128, QKV_N,
                                  Ab + (lrow + qb * 256) * D + hd * 64, D, 0, 128, false, qb * 256, scA, false, 0.f, 1, ROPE); }
                for (int u = vcu; u < 2048; u += G) { const int bh = u >> 5, qb = u & 31, b = bh >> 3, qh = bh & 7; const size_t lrow = (size_t)b * SEQ, crow_ = (size_t)TL + b * CTXN;
                    const int lo = (4 * qb - 2) < 0 ? 0 : 4 * qb - 2, hi = (4 * qb + 6) > 128 ? 128 : 4 * qb + 6;
                    attn_unit<64>(lds, PROJ + (lrow + qb * 256) * PROJ_N + 416 + qh * 64, PROJ_N, PROJ + crow_ * PROJ_N + 928 + (qh >> 2) * 64, PROJ + lrow * PROJ_N + 928 + (qh >> 2) * 64, PROJ_N,
                                  nullptr, nullptr, 0, PROJ + crow_ * PROJ_N + 1056 + (qh >> 2) * 64, PROJ + lrow * PROJ_N + 1056 + (qh >> 2) * 64, PROJ_N,
                                  Ab + (lrow + qb * 256) * D + 512 + qh * 64, D, lo, hi, true, qb * 256, scB, true, IN(I_SINK)[qh] * LOG2E, 2, ROPE); }
                for (int u = vcu; u < 64; u += G) { const int b = u >> 3, hd = u & 7; const size_t crow_ = (size_t)TL + b * CTXN;
                    attn_unit<96>(lds, QKV + crow_ * QKV_N + hd * 96, QKV_N, QKV + crow_ * QKV_N + 768 + hd * 128, QKV, QKV_N, PROJ + crow_ * PROJ_N + 384, PROJ, PROJ_N,
                                  QKV + crow_ * QKV_N + 832 + hd * 128, QKV, QKV_N, Ab + crow_ * D + hd * 64, D, 0, 0, false, 0, scA, false, 0.f, 0, ROPE);
                    attn_unit<64>(lds, PROJ + crow_ * PROJ_N + 416 + hd * 64, PROJ_N, PROJ + crow_ * PROJ_N + 928 + (hd >> 2) * 64, PROJ, PROJ_N, nullptr, nullptr, 0,
                                  PROJ + crow_ * PROJ_N + 1056 + (hd >> 2) * 64, PROJ, PROJ_N, Ab + crow_ * D + 512 + hd * 64, D, 0, 0, false, 0, scB, true, IN(I_SINK)[hd] * LOG2E, 0, ROPE); }
                }
            }
            GSYNC();
            { pg8::EpiBf16 e{Yb, D}; RUN_GEMM(pg8::EpiBf16, e, Ab, WOUTT, TA, 1024, 1024, 1024, 1024, NOGRP, 0); }
            GSYNC();
        } else {
            { TIDS
            const float* cre = IN(I_CRE); const float* cim = IN(I_CIM); const float* dsk = IN(I_S5D);
            for (int rep_ = 0; rep_ < PROBE_MISC; ++rep_) for (int i0 = gt; i0 < 64 * 1024 * 128; i0 += 4 * ngt) {
                f32x4 a0[4], a1[4], b0[4], b1[4]; float dg[4];
#pragma unroll
                for (int u = 0; u < 4; ++u) { const int i = i0 + u * ngt; if (i < 64 * 1024 * 128) { const int k8 = (i & 127) * 8, n = (i >> 7) & 1023, g = i >> 17, tp = n >> 4, hh = n & 15, sp = k8 >> 4, h0 = k8 & 15, dd = tp - sp, dA = dd > 0 ? dd : 0, dB = dd < 0 ? -dd : 0;
                    const f32x4* ka = (const f32x4*)(KTAB + ((((size_t)g * 2 + 0) * 64 + dA) * 16 + hh) * 16 + h0); const f32x4* kb = (const f32x4*)(KTAB + ((((size_t)g * 2 + 1) * 64 + dB) * 16 + hh) * 16 + h0);
                    a0[u] = ka[0]; a1[u] = ka[1]; b0[u] = kb[0]; b1[u] = kb[1]; dg[u] = (dd == 0) ? dsk[g * 16 + hh] : 0.f; } }
#pragma unroll
                for (int u = 0; u < 4; ++u) { const int i = i0 + u * ngt; if (i < 64 * 1024 * 128) { const int k8 = (i & 127) * 8, n = (i >> 7) & 1023, g = i >> 17, tp = n >> 4, hh = n & 15, sp = k8 >> 4, h0 = k8 & 15, dd = tp - sp; const float wa = dd >= 0 ? 1.f : 0.f, wb = dd <= 0 ? 1.f : 0.f; float v[8];
#pragma unroll
                    for (int j = 0; j < 4; ++j) { v[j] = wa * a0[u][j] + wb * b0[u][j] + ((h0 + j) == hh ? dg[u] : 0.f); v[4 + j] = wa * a1[u][j] + wb * b1[u][j] + ((h0 + 4 + j) == hh ? dg[u] : 0.f); }
                    u32x4 w; w.x = cvtpk(v[0], v[1]); w.y = cvtpk(v[2], v[3]); w.z = cvtpk(v[4], v[5]); w.w = cvtpk(v[6], v[7]); *(u32x4*)(BMm + ((size_t)g * 1024 + n) * XE_K + k8) = w; } } }
            for (int rep_ = 0; rep_ < PROBE_MISC; ++rep_) for (int i = gt; i < 64 * 1024 * 32; i += ngt) { const int kk = (i & 31) * 8, n = (i >> 5) & 1023, g = i >> 15, tp = n >> 4, hh = n & 15, dir = kk >> 7, ri = (kk >> 6) & 1, p0 = kk & 63, e = dir == 0 ? tp + 1 : 64 - tp; float v[8];
#pragma unroll
                for (int j = 0; j < 8; ++j) { const int p = p0 + j; const float pr = POW[(size_t)((dir * 64 + g) * 64 + p) * 130 + 2 * e], pi = POW[(size_t)((dir * 64 + g) * 64 + p) * 130 + 2 * e + 1];
                    const float cr = cre[((size_t)(dir * 64 + g) * 16 + hh) * 64 + p], ci = cim[((size_t)(dir * 64 + g) * 16 + hh) * 64 + p]; v[j] = ri == 0 ? cr * pr - ci * pi : -(cr * pi + ci * pr); }
                u32x4 w; w.x = cvtpk(v[0], v[1]); w.y = cvtpk(v[2], v[3]); w.z = cvtpk(v[4], v[5]); w.w = cvtpk(v[6], v[7]); *(u32x4*)(BMm + ((size_t)g * 1024 + n) * XE_K + 1024 + kk) = w; }
            for (int rep_ = 0; rep_ < PROBE_MISC; ++rep_) for (int i = gt; i < 64 * 256 * 128; i += ngt) { const int k8 = (i & 127) * 8, n = (i >> 7) & 255, g = i >> 15, dir = n >> 7, ri = (n >> 6) & 1, p = n & 63, sp = k8 >> 4, h0 = k8 & 15, e = dir == 0 ? 63 - sp : sp;
                const size_t ib = (size_t)((dir * 64 + g) * 64 + p); const float pr = POW[ib * 130 + 2 * e], pi = POW[ib * 130 + 2 * e + 1]; float v[8];
#pragma unroll
                for (int j = 0; j < 8; ++j) { const float br = BBAR[(ib * 16 + h0 + j) * 2], bi = BBAR[(ib * 16 + h0 + j) * 2 + 1]; v[j] = ri == 0 ? pr * br - pi * bi : pr * bi + pi * br; }
                u32x4 w; w.x = cvtpk(v[0], v[1]); w.y = cvtpk(v[2], v[3]); w.z = cvtpk(v[4], v[5]); w.w = cvtpk(v[6], v[7]); *(u32x4*)(BSm + ((size_t)g * 256 + n) * 1024 + k8) = w; }
            }
            { pg8::EpiS5In e{XE, UC}; RUN_GEMM(pg8::EpiS5In, e, Ab, S5INT, TA, 1024, 1024, 1024, 1024, NOGRP, 0); }
            GSYNC();
            { TIDS
            LAS float* su = (LAS float*)lds;
            for (int rep_ = 0; rep_ < PROBE_MISC; ++rep_) for (int pi0 = bx * 2; pi0 < 512; pi0 += G * 2) {
                __syncthreads();
#pragma unroll
                for (int k = 0; k < 4; ++k) { const int idx = tid + 512 * k, pr = idx >> 10, rem = idx & 1023, j = rem >> 2, q = rem & 3, pi = pi0 + pr;
                    if (pi < 512) ((LAS f32x4*)su)[idx] = *(const f32x4*)(UC + (size_t)((pi >> 6) * 256 + j) * D + (pi & 63) * 16 + 4 * q); }
                __syncthreads();
                if (wave < 4 && pi0 + (wave >> 1) < 512) { const int pi = pi0 + (wave >> 1), dir = wave & 1, b = pi >> 6, g = pi & 63, p = lane; const size_t ib = (size_t)((dir * 64 + g) * 64 + p);
                    const float are = ABAR[2 * ib], aim = ABAR[2 * ib + 1]; float br[16], bi[16];
#pragma unroll
                    for (int hh = 0; hh < 16; ++hh) { br[hh] = BBAR[(ib * 16 + hh) * 2]; bi[hh] = BBAR[(ib * 16 + hh) * 2 + 1]; }
                    float sr = 0.f, si = 0.f; const LAS f32x4* ub = (const LAS f32x4*)su + (wave >> 1) * 1024;
#pragma unroll 4
                    for (int jj = 0; jj < 256; ++jj) { const int j = dir == 0 ? jj : 255 - jj; const LAS f32x4* up = ub + j * 4; float ur = 0.f, ui = 0.f;
#pragma unroll
                        for (int q = 0; q < 4; ++q) { const f32x4 uv = up[q]; ur += uv.x * br[4 * q] + uv.y * br[4 * q + 1] + uv.z * br[4 * q + 2] + uv.w * br[4 * q + 3]; ui += uv.x * bi[4 * q] + uv.y * bi[4 * q + 1] + uv.z * bi[4 * q + 2] + uv.w * bi[4 * q + 3]; }
                        const float nr = are * sr - aim * si + ur, ni = are * si + aim * sr + ui; sr = nr; si = ni; }
                    SCTX[(((size_t)b * 64 + g) * 2 + dir) * 128 + p] = sr; SCTX[(((size_t)b * 64 + g) * 2 + dir) * 128 + 64 + p] = si; }
            }
            __syncthreads();
            }
            { pg8::EpiF32 e{Eb, 256}; RUN_GEMM(pg8::EpiF32, e, XE, BSm, 64 * 1024, 256, 1024, XE_K, 1024, 4, 256 * 1024); }
            GSYNC();
            { TIDS
            for (int rep_ = 0; rep_ < PROBE_MISC; ++rep_) for (int i = gt; i < 8 * 64 * 2 * 64; i += ngt) { const int p = i & 63, dir = (i >> 6) & 1, g = (i >> 7) & 63, b = i >> 13; const size_t ib = (size_t)((dir * 64 + g) * 64 + p);
                const float are = POW[ib * 130 + 128], aim = POW[ib * 130 + 129];
                float sr = SCTX[(((size_t)b * 64 + g) * 2 + dir) * 128 + p], si = SCTX[(((size_t)b * 64 + g) * 2 + dir) * 128 + 64 + p];
                for (int cb = 0; cb < 128; cb += 8) { float er[8], ei[8];
#pragma unroll
                    for (int u = 0; u < 8; ++u) { const int c = dir == 0 ? cb + u : 127 - (cb + u); const size_t row = (size_t)g * 1024 + b * 128 + c; er[u] = Eb[row * 256 + dir * 128 + p]; ei[u] = Eb[row * 256 + dir * 128 + 64 + p]; }
#pragma unroll
                    for (int u = 0; u < 8; ++u) { const int c = dir == 0 ? cb + u : 127 - (cb + u); const size_t row = (size_t)g * 1024 + b * 128 + c;
                        XE[row * XE_K + 1024 + dir * 128 + p] = (bf16_t)f2bf(sr); XE[row * XE_K + 1024 + dir * 128 + 64 + p] = (bf16_t)f2bf(si);
                        const float nr = are * sr - aim * si + er[u], ni = are * si + aim * sr + ei[u]; sr = nr; si = ni; } } }
            }
            GSYNC();
            { pg8::EpiS5Out e{Ab}; RUN_GEMM(pg8::EpiS5Out, e, XE, BMm, 64 * 1024, 1024, XE_K, XE_K, XE_K, 4, 1024 * XE_K); }
            GSYNC();
            { pg8::EpiGlu e{Yb}; RUN_GEMM(pg8::EpiGlu, e, Ab, GLUT, TL, 2048, 1024, 1024, 1024, NOGRP, 0); }
            GSYNC();
        }
        const int nr2 = l == 0 ? TA : TL;
        {
            TIDS
            RowOp o{HB, HCTX, true, HB, HCTX, true, Yb, npost + D, MODL, 5, 1.0f, npre + 2 * D, MODL, 6, 7, Ab, nr2};
            row_phase(o, gw, ngw, lane);
        }
        GSYNC();
        for (int rep_ = 0; rep_ < PROBE_G1; ++rep_) { pg8::EpiSwiglu e{Ub}; RUN_GEMM(pg8::EpiSwiglu, e, Ab, W13T + (size_t)(l * 2 + 1) * 5632 * 1024, nr2, 5632, 1024, 1024, 1024, NOGRP, 0); }
        GSYNC();
        for (int rep_ = 0; rep_ < PROBE_G2; ++rep_) { pg8::EpiBf16 e{Yb, D}; RUN_GEMM(pg8::EpiBf16, e, Ub, W2T + (size_t)(l * 2 + 1) * 1024 * 2816, nr2, 1024, 2816, 2816, 2816, NOGRP, 0); }
        GSYNC();
        {
            TIDS
            RowOp o{HB, HCTX, true, l == 0 ? (void*)HB : (void*)OUT, HCTX, l == 0, Yb, npost + 2 * D, MODL, 8, 0.5f, l == 0 ? IN(I_NPRE) + 3 * D : nullptr, MOD1, 0, 1, Ab, nr2};
            row_phase(o, gw, ngw, lane);
        }
        if (l == 0) GSYNC();
}

__global__ void __launch_bounds__(512, 2) fwd_megakernel(Args args) {
    extern __shared__ __attribute__((aligned(16))) unsigned char lds_raw[];
    LAS unsigned char* lds = (LAS unsigned char*)lds_raw;
    cg::grid_group grid = cg::this_grid();
    {
        if (threadIdx.x < 2) ((LAS unsigned*)(lds + XB_LDS_OFF))[threadIdx.x] = 0u;
        if (blockIdx.x == 0) { GAS unsigned* bw = (GAS unsigned*)args.ws; for (int i = threadIdx.x; i < XCD_BAR_WORDS; i += 512) bw[i] = 0u; }
        __syncthreads();
    }
    for (int rep_ = 0; rep_ < PROBE_MISC * PROBE_PRO; ++rep_) { prologue_phase(args, lds); __syncthreads(); }
    grid.sync();
    if (threadIdx.x == 0) (void)xb_add((unsigned*)args.ws + XB_XCNT(xb_xcc_id()), 1u);
    layer_phase<0>(args, lds, grid);
    layer_phase<1>(args, lds, grid);
}

extern "C" void kernel_launch(void* const* d_in, const int* in_sizes, int n_in, void* d_out, int out_size, void* d_ws, size_t ws_size, hipStream_t stream) {
    static int grid_blocks = 0;
    if (grid_blocks == 0) {
        if (n_in != 27 || out_size != TL * D || ws_size < WS_END) { fprintf(stderr, "kernel_launch: unexpected shapes (n_in %d out %d ws %zu)\n", n_in, out_size, ws_size); grid_blocks = -1; return; }
        int dev = 0, cus = 0, per_cu = 0;
        hipGetDevice(&dev);
        hipDeviceGetAttribute(&cus, hipDeviceAttributeMultiprocessorCount, dev);
        hipFuncSetAttribute((const void*)fwd_megakernel, hipFuncAttributeMaxDynamicSharedMemorySize, LDS_BYTES);
        hipOccupancyMaxActiveBlocksPerMultiprocessor(&per_cu, (const void*)fwd_megakernel, 512, LDS_BYTES);
        if (per_cu < 1) per_cu = 1;
        grid_blocks = cus * per_cu;
        (void)hipGetLastError();
    }
    if (grid_blocks < 0) return;
    Args a{};
    for (int i = 0; i < 27; ++i) a.in[i] = (const float*)d_in[i];
    a.out = (float*)d_out; a.ws = (unsigned char*)d_ws;
    void* kargs[] = {&a};
    hipError_t e = hipLaunchCooperativeKernel((const void*)fwd_megakernel, dim3(grid_blocks), dim3(512), kargs, LDS_BYTES, stream);
    if (e != hipSuccess) fprintf(stderr, "cooperative launch failed: %s (grid %d)\n", hipGetErrorString(e), grid_blocks);
}
```

```cpp
#include <hip/hip_runtime.h>
#include <hip/hip_cooperative_groups.h>
#include <cstdio>
#include <cstdint>
namespace cg = cooperative_groups;

#define LAS __attribute__((address_space(3)))
#define DI __device__ __forceinline__
typedef unsigned short bf16_t;
typedef short bf16x8 __attribute__((ext_vector_type(8)));
typedef short s16x4 __attribute__((ext_vector_type(4)));
typedef float f32x4 __attribute__((ext_vector_type(4)));
typedef float f32x16 __attribute__((ext_vector_type(16)));
typedef unsigned u32x4 __attribute__((ext_vector_type(4)));
typedef unsigned u32x2 __attribute__((ext_vector_type(2)));
typedef float f32x2_t __attribute__((ext_vector_type(2)));
typedef __bf16 bf16x2_t __attribute__((ext_vector_type(2)));

constexpr int D = 1024, FF = 2816, TL = 65536, TC = 2048, TA = TL + TC, SEQ = 8192, CTXN = 256, NBATCH = 8;
constexpr int PROJ_N = 1280, CN_N = 384, QKV_N = 1792, XE_K = 1280;
constexpr float EPSV = 1e-6f;
constexpr float LOG2E = 1.4426950408889634f;
constexpr size_t MiB = (size_t)1 << 20;
constexpr size_t WS_MOD = 1 * MiB, WS_ROPE = 2 * MiB, WS_ABAR = 3 * MiB, WS_BBAR = 4 * MiB, WS_POW = 5 * MiB, WS_KTAB = 10 * MiB, WS_SCTX = 18 * MiB;
constexpr size_t WS_W13T = 20 * MiB, WS_W2T = 64 * MiB, WS_WINT = 86 * MiB, WS_WUT = 89 * MiB, WS_WOUTT = 91 * MiB, WS_S5INT = 93 * MiB, WS_GLUT = 95 * MiB;
constexpr size_t WS_HCTX = 100 * MiB, WS_A = 108 * MiB, WS_Y = 240 * MiB, WS_SCR = 504 * MiB;
constexpr size_t WS_U = WS_SCR;
constexpr size_t WS_PROJ = WS_SCR, WS_CN = WS_SCR + 166 * MiB, WS_QKV = WS_SCR + 216 * MiB;
constexpr size_t WS_XE = WS_SCR, WS_UC = WS_SCR + 160 * MiB, WS_E = WS_SCR + 168 * MiB, WS_BM = WS_SCR + 232 * MiB, WS_BS = WS_SCR + 392 * MiB;
constexpr size_t WS_END = 1024 * MiB;
static_assert(WS_U + (size_t)TA * FF * 2 <= WS_END, "U");
static_assert(WS_PROJ + (size_t)TA * PROJ_N * 2 <= WS_CN && WS_CN + (size_t)TA * CN_N * 2 <= WS_QKV && WS_QKV + (size_t)TA * QKV_N * 2 <= WS_END, "attn scratch");
static_assert(WS_BS + (size_t)64 * 256 * 1024 * 2 <= WS_END && WS_BM + (size_t)64 * 1024 * XE_K * 2 <= WS_BS, "s5 scratch");
constexpr size_t WS_HB = 372 * MiB;
static_assert(WS_A + (size_t)TA * D * 2 <= WS_Y && WS_Y + (size_t)TA * D * 2 <= WS_HB && WS_HB + (size_t)TL * D * 2 <= WS_SCR, "A/Y/HB");
#ifndef PROBE_ATT
#define PROBE_ATT 1
#endif
#ifndef PROBE_PRO
#define PROBE_PRO 1
#endif
#ifndef PROBE_MISC
#define PROBE_MISC 1
#endif
#ifndef PROBE_SYNC
#define PROBE_SYNC 1
#endif
#ifndef PROBE_G1
#define PROBE_G1 1
#endif
#ifndef PROBE_G2
#define PROBE_G2 1
#endif
constexpr int LDS_BYTES = 147456;

#define GAS __attribute__((address_space(1)))
template <class T> DI T* gl(T* p) { return (T*)(GAS T*)p; }
DI unsigned f2bf(float f) { unsigned u = __builtin_bit_cast(unsigned, f); return (u + 0x7fffu + ((u >> 16) & 1u)) >> 16; }
DI unsigned cvtpk(float lo, float hi) { f32x2_t v = {lo, hi}; bf16x2_t b = __builtin_convertvector(v, bf16x2_t); return __builtin_bit_cast(unsigned, b); }
DI float bf2f(unsigned short b) { return __builtin_bit_cast(float, (unsigned)b << 16); }
DI float wave_sum(float v) {
    v += __builtin_bit_cast(float, __builtin_amdgcn_update_dpp(0, __builtin_bit_cast(int, v), 0xB1, 0xf, 0xf, true));
    v += __builtin_bit_cast(float, __builtin_amdgcn_update_dpp(0, __builtin_bit_cast(int, v), 0x4E, 0xf, 0xf, true));
    v += __builtin_bit_cast(float, __builtin_amdgcn_update_dpp(0, __builtin_bit_cast(int, v), 0x141, 0xf, 0xf, true));
    v += __builtin_bit_cast(float, __builtin_amdgcn_update_dpp(0, __builtin_bit_cast(int, v), 0x140, 0xf, 0xf, true));
    { auto rr = __builtin_amdgcn_permlane16_swap(__float_as_uint(v), __float_as_uint(v), false, false); v = __uint_as_float(rr[0]) + __uint_as_float(rr[1]); }
    { auto rr = __builtin_amdgcn_permlane32_swap(__float_as_uint(v), __float_as_uint(v), false, false); v = __uint_as_float(rr[0]) + __uint_as_float(rr[1]); }
    return v;
}
DI float sigm(float x) { return __builtin_amdgcn_rcpf(1.f + __expf(-x)); }
DI void sincos_rad_d(double ang, float& s, float& c) { double rev = ang * 0.15915494309189535; rev -= __builtin_rint(rev); const float f = (float)rev; s = __builtin_amdgcn_sinf(f); c = __builtin_amdgcn_cosf(f); }

namespace pg8 {
constexpr int BM = 256, BK = 64, HALF = 128, HTB = HALF * BK * 2, STAGE_BYTES = 8 * HTB, NXCD = 8, WGM = 8;
DI int lds_byte(int r, int c) { const int st = (r >> 4) * 2 + (c >> 5), rr = r & 15, cc = c & 31, ob = rr * 64 + cc * 2; return st * 1024 + (ob ^ (((ob >> 9) & 1) << 5)); }
DI void stage_rc(int b, int& R, int& C) { const int st = b / 1024, sb = b % 1024, swz = sb ^ (((sb >> 9) & 1) << 5); R = (st >> 1) * 16 + swz / 64; C = (st & 1) * 32 + (swz % 64) / 2; }
DI int perm32(int rho) { const int n = rho >> 4, i = rho & 15; return 8 * (i >> 2) + 4 * n + (i & 3); }
struct Unit { int pm, pn; };
struct Gemm { const bf16_t* A; const bf16_t* Bt; int M, N, K, lda, ldb, mt_per_group; size_t strideB; };
struct StaticOrder {
    int nM, nN, nwg, G, c;
    DI void init(int M, int N, int G_, int c_) { nM = M / BM; nN = N / BM; nwg = nM * nN; G = G_; c = c_; }
    DI bool next(int i, Unit& u) const {
        const long L = (long)i * G + c; if (L >= nwg) return false;
        int wgid = (int)L; { const int q = nwg / NXCD, r = nwg % NXCD, xcd = wgid % NXCD, off = wgid / NXCD; wgid = (xcd < r ? xcd * (q + 1) : r * (q + 1) + (xcd - r) * q) + off; }
        const int nig = WGM * nN, gid = wgid / nig, fm = gid * WGM, gsz = (nM - fm) < WGM ? (nM - fm) : WGM;
        u.pm = fm + ((wgid % nig) % gsz); u.pn = (wgid % nig) / gsz; return true;
    }
};
template <class Epi>
DI void gemm_phase(LAS unsigned char* lds, const Gemm g, const StaticOrder& S, const Epi& E) {
    int tid_ = threadIdx.x; asm volatile("" : "+v"(tid_));
    const int tid = tid_, wid = __builtin_amdgcn_readfirstlane(tid >> 6), lane = tid & 63, wr = wid >> 2, wc = wid & 3, fr = lane & 15, fq = lane >> 4;
    const int K = g.K, nt = K / BK;
    unsigned voffA[2], voffB[2];
#pragma unroll
    for (int i = 0; i < 2; ++i) { int R, C; stage_rc(tid * 16 + i * 8192, R, C); const int Rb = Epi::PERM ? ((R & ~31) + perm32(R & 31)) : R;
        voffA[i] = (unsigned)(R * g.lda + C) * 2u; voffB[i] = (unsigned)(Rb * g.ldb + C) * 2u; }
    const size_t kstep = (size_t)(BK * 2);
    const size_t hstepA = (size_t)HALF * g.lda * 2, hstepB = (size_t)HALF * g.ldb * 2, tstepA = 2 * hstepA, tstepB = 2 * hstepB;
    const unsigned ldsw = (unsigned)wid * 1024u;
    const int aoff = lds_byte(wr * 64 + fr, fq * 8), boff = lds_byte(wc * 32 + fr, fq * 8);
#define PG8_SA(b, h) (((b) * 2 + (h)) * HTB)
#define PG8_SB(b, h) ((4 + (b) * 2 + (h)) * HTB)
#define PG8_STAGE(bufoff, gbase, voff) do { _Pragma("unroll") for (int _i = 0; _i < 2; ++_i) \
        __builtin_amdgcn_global_load_lds((const unsigned*)((const char*)(gbase) + (voff)[_i]), (LAS unsigned*)(lds + (bufoff) + ldsw + _i * 8192), 16, 0, 0); } while (0)
#define PG8_LDA(dst, b, h) do { _Pragma("unroll") for (int m = 0; m < 4; ++m) _Pragma("unroll") for (int k = 0; k < 2; ++k) dst[m][k] = *(const LAS bf16x8*)(lds + PG8_SA(b, h) + aoff + m * 2048 + k * 1024); } while (0)
#define PG8_LDB(dst, b, h) do { _Pragma("unroll") for (int n = 0; n < 2; ++n) _Pragma("unroll") for (int k = 0; k < 2; ++k) dst[n][k] = *(const LAS bf16x8*)(lds + PG8_SB(b, h) + boff + n * 2048 + k * 1024); } while (0)
#define PG8_MMA(ai, bj, At, Bt) do { __builtin_amdgcn_s_setprio(1); _Pragma("unroll") for (int m = 0; m < 4; ++m) _Pragma("unroll") for (int n = 0; n < 2; ++n) _Pragma("unroll") for (int k = 0; k < 2; ++k) \
        acc[ai][bj][m][n] = __builtin_amdgcn_mfma_f32_16x16x32_bf16(Bt[n][k], At[m][k], acc[ai][bj][m][n], 0, 0, 0); __builtin_amdgcn_s_setprio(0); } while (0)
#define PG8_WAIT_V(n) asm volatile("s_waitcnt vmcnt(" #n ")" ::: "memory")
#define PG8_WAIT_L(n) asm volatile("s_waitcnt lgkmcnt(" #n ")" ::: "memory")
#define PG8_BAR __builtin_amdgcn_s_barrier()
#define PG8_SCHED __builtin_amdgcn_sched_barrier(0)
#define PG8_BPTR(u) ((const char*)g.Bt + (size_t)((u).pm / g.mt_per_group) * g.strideB * 2 + (size_t)(u).pn * tstepB)
    Unit cur, nxt; int ui = 0;
    if (!S.next(0, cur)) return;
    f32x4 acc[2][2][4][2];
#pragma unroll
    for (int a = 0; a < 2; ++a)
#pragma unroll
        for (int b = 0; b < 2; ++b)
#pragma unroll
            for (int m = 0; m < 4; ++m)
#pragma unroll
                for (int n = 0; n < 2; ++n) acc[a][b][m][n] = (f32x4){0.f, 0.f, 0.f, 0.f};
    bf16x8 At[4][2], B0[2][2], B1[2][2];
    const char* cA = (const char*)g.A + (size_t)cur.pm * tstepA; const char* cB = PG8_BPTR(cur);
    PG8_STAGE(PG8_SB(0, 0), cB, voffB); PG8_STAGE(PG8_SB(0, 1), cB + hstepB, voffB); PG8_STAGE(PG8_SA(0, 0), cA, voffA); PG8_STAGE(PG8_SA(0, 1), cA + hstepA, voffA);
    if (wr == 1) PG8_BAR;
    PG8_WAIT_V(2); PG8_BAR;
    PG8_STAGE(PG8_SB(1, 0), cB + kstep, voffB); PG8_STAGE(PG8_SA(1, 0), cA + kstep, voffA); PG8_STAGE(PG8_SB(1, 1), cB + hstepB + kstep, voffB);
    PG8_WAIT_V(6); PG8_BAR;
    for (;;) {
        const bool has_next = S.next(ui + 1, nxt);
        const char* nA = has_next ? (const char*)g.A + (size_t)nxt.pm * tstepA : cA; const char* nB = has_next ? PG8_BPTR(nxt) : cB;
        for (int t = 0; t < nt; t += 2) {
            const bool last = (t == nt - 2);
            const char* a1 = cA + (size_t)(t + 1) * kstep;
            const char* a2 = last ? nA : cA + (size_t)(t + 2) * kstep; const char* b2 = last ? nB : cB + (size_t)(t + 2) * kstep;
            const char* a3 = a2 + kstep; const char* b3 = b2 + kstep;
            PG8_LDB(B0, 0, 0); PG8_LDB(B1, 0, 1); PG8_SCHED; PG8_LDA(At, 0, 0); PG8_STAGE(PG8_SA(1, 1), a1 + hstepA, voffA);
            PG8_WAIT_V(8); PG8_WAIT_L(0); PG8_BAR; PG8_MMA(0, 0, At, B0); PG8_MMA(0, 1, At, B1); PG8_BAR; PG8_SCHED;
            PG8_LDA(At, 0, 1); PG8_STAGE(PG8_SB(0, 0), b2, voffB); PG8_STAGE(PG8_SB(0, 1), b2 + hstepB, voffB); PG8_STAGE(PG8_SA(0, 0), a2, voffA);
            PG8_WAIT_V(8); PG8_WAIT_L(0); PG8_BAR; PG8_MMA(1, 0, At, B0); PG8_MMA(1, 1, At, B1); PG8_BAR; PG8_SCHED;
            PG8_LDB(B0, 1, 0); PG8_LDB(B1, 1, 1); PG8_SCHED; PG8_LDA(At, 1, 0); PG8_STAGE(PG8_SA(0, 1), a2 + hstepA, voffA);
            PG8_WAIT_V(8); PG8_WAIT_L(0); PG8_BAR; PG8_MMA(0, 0, At, B0); PG8_MMA(0, 1, At, B1); PG8_BAR; PG8_SCHED;
            PG8_LDA(At, 1, 1); PG8_STAGE(PG8_SB(1, 0), b3, voffB); PG8_STAGE(PG8_SB(1, 1), b3 + hstepB, voffB); PG8_STAGE(PG8_SA(1, 0), a3, voffA);
            PG8_WAIT_V(8); PG8_WAIT_L(0); PG8_BAR; PG8_MMA(1, 0, At, B0); PG8_MMA(1, 1, At, B1); PG8_BAR; PG8_SCHED;
        }
        if (wr == 0) PG8_BAR;
        { int t2_ = threadIdx.x; asm volatile("" : "+v"(t2_)); const int w2_ = t2_ >> 6, l2_ = t2_ & 63; E(acc, cur, w2_ >> 2, w2_ & 3, l2_ & 15, l2_ >> 4); }
        if (!has_next) break;
#pragma unroll
        for (int a = 0; a < 2; ++a)
#pragma unroll
            for (int b = 0; b < 2; ++b)
#pragma unroll
                for (int m = 0; m < 4; ++m)
#pragma unroll
                    for (int n = 0; n < 2; ++n) acc[a][b][m][n] = (f32x4){0.f, 0.f, 0.f, 0.f};
        cur = nxt; cA = nA; cB = nB; ++ui;
        if (wr == 1) PG8_BAR;
    }
    PG8_WAIT_V(0);
    PG8_BAR;
#undef PG8_SA
#undef PG8_SB
#undef PG8_STAGE
#undef PG8_LDA
#undef PG8_LDB
#undef PG8_MMA
#undef PG8_WAIT_V
#undef PG8_WAIT_L
#undef PG8_BAR
#undef PG8_SCHED
#undef PG8_BPTR
}
typedef f32x4 Acc[2][2][4][2];
DI u32x4 pack8(const f32x4 v0, const f32x4 v1) { u32x4 w; w.x = cvtpk(v0[0], v0[1]); w.y = cvtpk(v0[2], v0[3]); w.z = cvtpk(v1[0], v1[1]); w.w = cvtpk(v1[2], v1[3]); return w; }
struct EpiBf16 {
    static constexpr bool PERM = true; bf16_t* O; int ldc;
    DI void operator()(const Acc& acc, const Unit& u, int wr, int wc, int fr, int fq) const {
        const int row0 = u.pm * BM + wr * 64 + fr, col0 = u.pn * BM + wc * 32 + 8 * fq;
#pragma unroll
        for (int ai = 0; ai < 2; ++ai)
#pragma unroll
            for (int m = 0; m < 4; ++m) { bf16_t* rowp = O + (size_t)(row0 + ai * HALF + m * 16) * ldc + col0;
#pragma unroll
                for (int bj = 0; bj < 2; ++bj) *(u32x4*)(rowp + bj * HALF) = pack8(acc[ai][bj][m][0], acc[ai][bj][m][1]); }
    }
};
struct EpiSwiglu {
    static constexpr bool PERM = true; bf16_t* O;
    DI void operator()(const Acc& acc, const Unit& u, int wr, int wc, int fr, int fq) const {
        const int row0 = u.pm * BM + wr * 64 + fr, col0 = u.pn * HALF + wc * 32 + 8 * fq;
#pragma unroll
        for (int ai = 0; ai < 2; ++ai)
#pragma unroll
            for (int m = 0; m < 4; ++m) { f32x4 r0, r1;
#pragma unroll
                for (int j = 0; j < 4; ++j) { const float g0 = acc[ai][0][m][0][j], g1 = acc[ai][0][m][1][j]; r0[j] = g0 * sigm(g0) * acc[ai][1][m][0][j]; r1[j] = g1 * sigm(g1) * acc[ai][1][m][1][j]; }
                *(u32x4*)(O + (size_t)(row0 + ai * HALF + m * 16) * FF + col0) = pack8(r0, r1); }
    }
};
struct EpiF32 {
    static constexpr bool PERM = false; float* O; int ldc;
    DI void operator()(const Acc& acc, const Unit& u, int wr, int wc, int fr, int fq) const {
        const int row0 = u.pm * BM + wr * 64 + fr, col0 = u.pn * BM + wc * 32 + 4 * fq;
#pragma unroll
        for (int ai = 0; ai < 2; ++ai)
#pragma unroll
            for (int m = 0; m < 4; ++m) { float* rowp = O + (size_t)(row0 + ai * HALF + m * 16) * ldc + col0;
#pragma unroll
                for (int bj = 0; bj < 2; ++bj)
#pragma unroll
                    for (int n = 0; n < 2; ++n) *(f32x4*)(rowp + bj * HALF + n * 16) = acc[ai][bj][m][n]; }
    }
};
struct EpiGlu {
    static constexpr bool PERM = true; bf16_t* O;
    DI void operator()(const Acc& acc, const Unit& u, int wr, int wc, int fr, int fq) const {
        const int row0 = u.pm * BM + wr * 64 + fr, col0 = u.pn * HALF + wc * 32 + 8 * fq;
#pragma unroll
        for (int ai = 0; ai < 2; ++ai)
#pragma unroll
            for (int m = 0; m < 4; ++m) { f32x4 r0, r1;
#pragma unroll
                for (int j = 0; j < 4; ++j) { r0[j] = acc[ai][0][m][0][j] * sigm(acc[ai][1][m][0][j]); r1[j] = acc[ai][0][m][1][j] * sigm(acc[ai][1][m][1][j]); }
                *(u32x4*)(O + (size_t)(row0 + ai * HALF + m * 16) * D + col0) = pack8(r0, r1); }
    }
};
struct EpiS5In {
    static constexpr bool PERM = true; bf16_t* XE; float* UC;
    DI void operator()(const Acc& acc, const Unit& u, int wr, int wc, int fr, int fq) const {
        const int row0 = u.pm * BM + wr * 64 + fr, col0 = u.pn * BM + wc * 32 + 8 * fq;
#pragma unroll
        for (int ai = 0; ai < 2; ++ai)
#pragma unroll
            for (int m = 0; m < 4; ++m) { const int row = row0 + ai * HALF + m * 16;
#pragma unroll
                for (int bj = 0; bj < 2; ++bj) { const int c8 = col0 + bj * HALF;
                    if (row < TL) { const int b = row >> 13, s = row & 8191, gi = c8 >> 4;
                        *(u32x4*)(XE + ((size_t)(gi * 1024 + b * 128 + (s >> 6)) * XE_K + (s & 63) * 16 + (c8 & 15))) = pack8(acc[ai][bj][m][0], acc[ai][bj][m][1]); }
                    else { float* p = UC + (size_t)(row - TL) * D + c8; *(f32x4*)p = acc[ai][bj][m][0]; *(f32x4*)(p + 4) = acc[ai][bj][m][1]; } } }
    }
};
struct EpiS5Out {
    static constexpr bool PERM = true; bf16_t* YG;
    DI void operator()(const Acc& acc, const Unit& u, int wr, int wc, int fr, int fq) const {
        const int row0 = u.pm * BM + wr * 64 + fr, col0 = u.pn * BM + wc * 32 + 8 * fq;
#pragma unroll
        for (int ai = 0; ai < 2; ++ai)
#pragma unroll
            for (int m = 0; m < 4; ++m) { const int rf = row0 + ai * HALF + m * 16, gi = rf >> 10, r = rf & 1023, b = r >> 7, c = r & 127;
#pragma unroll
                for (int bj = 0; bj < 2; ++bj) { const int n8 = col0 + bj * HALF, tp = n8 >> 4, ho = n8 & 15; f32x4 r0, r1;
#pragma unroll
                    for (int j = 0; j < 4; ++j) { const float y0 = acc[ai][bj][m][0][j], y1 = acc[ai][bj][m][1][j];
                        r0[j] = y0 * sigm(1.5957691216f * (y0 + 0.044715f * y0 * y0 * y0)); r1[j] = y1 * sigm(1.5957691216f * (y1 + 0.044715f * y1 * y1 * y1)); }
                    *(u32x4*)(YG + (size_t)(b * SEQ + c * 64 + tp) * D + gi * 16 + ho) = pack8(r0, r1); } }
    }
};
}

DI int crow(int i, int h) { return (i & 3) + 8 * (i >> 2) + 4 * h; }
DI bf16x8 rope_pair_lo(const bf16x8 x1, const bf16x8 x2, const float* cs, const float* sn, bf16x8& out2) {
    bf16x8 o1;
#pragma unroll
    for (int j = 0; j < 8; ++j) { const float a = bf2f((unsigned short)x1[j]), b = bf2f((unsigned short)x2[j]), c = cs[j], s = sn[j];
        o1[j] = (short)f2bf(a * c - b * s); out2[j] = (short)f2bf(a * s + b * c); }
    return o1;
}
template <int DQK>
DI void attn_unit(LAS unsigned char* lds, const bf16_t* Qrow0, int qpitch,
                  const bf16_t* KA_ctx, const bf16_t* KA_lat, int pA, const bf16_t* KB_ctx, const bf16_t* KB_lat, int pB,
                  const bf16_t* V_ctx, const bf16_t* V_lat, int pV, bf16_t* Orow0, int opitch,
                  int t_lo2, int t_hi2, bool band, int q0, float sc, bool has_sink, float sink_l2, int rope, const float* ropeT) {
    constexpr int NCH = DQK / 8, KP = DQK + 8, VP = 96, ND = DQK / 16;
    constexpr int KBUF = 64 * KP * 2, VBUF = 64 * VP * 2, VOFF = 2 * KBUF;
    int tid_ = threadIdx.x; asm volatile("" : "+v"(tid_));
    const int tid = tid_, lane = tid & 63, wid = __builtin_amdgcn_readfirstlane(tid >> 6), r = lane & 31, h = lane >> 5;
    const int ntl = 4 + (t_hi2 - t_lo2);
    const bool k1v = (tid + 512) < 64 * NCH;
    const int grp = wid >> 2;
    u32x4 kr0, kr1 = (u32x4){0u, 0u, 0u, 0u}, vr;
#define AT_LOADK(t) do { const bool ic_ = (t) < 4; const int rb_ = ic_ ? (t) * 64 : (t_lo2 + (t) - 4) * 64; \
        { const int ch_ = tid, row_ = ch_ / NCH, c_ = ch_ % NCH; const bf16_t* s_ = (DQK == 64 || c_ < 8) ? (ic_ ? KA_ctx : KA_lat) + (size_t)(rb_ + row_) * pA + c_ * 8 : (ic_ ? KB_ctx : KB_lat) + (size_t)(rb_ + row_) * pB + (c_ - 8) * 8; kr0 = *(const u32x4*)s_; } \
        if (k1v) { const int ch_ = tid + 512, row_ = ch_ / NCH, c_ = ch_ % NCH; const bf16_t* s_ = (DQK == 64 || c_ < 8) ? (ic_ ? KA_ctx : KA_lat) + (size_t)(rb_ + row_) * pA + c_ * 8 : (ic_ ? KB_ctx : KB_lat) + (size_t)(rb_ + row_) * pB + (c_ - 8) * 8; kr1 = *(const u32x4*)s_; } } while (0)
#define AT_LOADV(t) do { const bool ic_ = (t) < 4; const int rb_ = ic_ ? (t) * 64 : (t_lo2 + (t) - 4) * 64; \
        { const int row_ = tid >> 3, c_ = tid & 7; vr = *(const u32x4*)((ic_ ? V_ctx : V_lat) + (size_t)(rb_ + row_) * pV + c_ * 8); } } while (0)
#define AT_STOREK(buf) do { { const int ch_ = tid, row_ = ch_ / NCH, c_ = ch_ % NCH; *(LAS u32x4*)(lds + (buf) * KBUF + (row_ * KP + c_ * 8) * 2) = kr0; } \
        if (k1v) { const int ch_ = tid + 512, row_ = ch_ / NCH, c_ = ch_ % NCH; *(LAS u32x4*)(lds + (buf) * KBUF + (row_ * KP + c_ * 8) * 2) = kr1; } } while (0)
#define AT_STOREV(buf) do { const int row_ = tid >> 3, c_ = tid & 7; *(LAS u32x4*)(lds + VOFF + (buf) * VBUF + (row_ * VP + c_ * 8) * 2) = vr; } while (0)
    AT_LOADK(0);
    bf16x8 qf[ND];
    { const bf16_t* qrow = Qrow0 + (size_t)(wid * 32 + r) * qpitch;
#pragma unroll
      for (int d0 = 0; d0 < ND; ++d0) qf[d0] = *(const bf16x8*)(qrow + 16 * d0 + 8 * h);
      if (rope) { const int pos = q0 + wid * 32 + r, rr = pos >> 6, cc = pos & 63;
        if (DQK == 96) { const float* cA = ropeT; const float* sA = ropeT + 1024; const int p = h ? cc : rr;
            bf16x8 o2; const bf16x8 o1 = rope_pair_lo(qf[ND - 2], qf[ND - 1], cA + p * 8, sA + p * 8, o2); qf[ND - 2] = o1; qf[ND - 1] = o2; }
        else { const float* cB = ropeT + 2048; const float* sB = ropeT + 4096;
            bf16x8 o2; bf16x8 o1 = rope_pair_lo(qf[0], qf[2], cB + rr * 16 + 8 * h, sB + rr * 16 + 8 * h, o2); qf[0] = o1; qf[2] = o2;
            o1 = rope_pair_lo(qf[1], qf[3], cB + cc * 16 + 8 * h, sB + cc * 16 + 8 * h, o2); qf[1] = o1; qf[3] = o2; } }
#pragma unroll
      for (int d0 = 0; d0 < ND; ++d0) { u32x4 w;
#pragma unroll
        for (int j = 0; j < 4; ++j) w[j] = cvtpk(bf2f((unsigned short)qf[d0][2 * j]) * sc, bf2f((unsigned short)qf[d0][2 * j + 1]) * sc);
        qf[d0] = __builtin_bit_cast(bf16x8, w); } }
    float m_run = has_sink ? sink_l2 : 0.f, l_run = (has_sink && h == 0) ? 1.f : 0.f;
    bool started = false;
    f32x16 o0, o1, p0, p1, negm;
#pragma unroll
    for (int i = 0; i < 16; ++i) { o0[i] = 0.f; o1[i] = 0.f; p0[i] = 0.f; p1[i] = 0.f; negm[i] = -m_run; }
    bf16x8 pa[2][2];
#pragma unroll
    for (int a = 0; a < 2; ++a)
#pragma unroll
        for (int b = 0; b < 2; ++b) pa[a][b] = (bf16x8){0, 0, 0, 0, 0, 0, 0, 0};
    const int qw = q0 + wid * 32;
    const int vlane = (((lane & 15) >> 2) * VP + 16 * ((lane >> 4) & 1)) * 2 + 8 * (lane & 3) + (4 * h) * VP * 2;
    AT_STOREK(0);
    if (1 < ntl) AT_LOADK(1);
    AT_LOADV(0);
    __syncthreads();
    if (grp == 1) __syncthreads();
    bool act = false, act_prev = false; int kt0 = 0;
    for (int t = 0; t <= ntl; ++t) {
        if (t + 1 < ntl) AT_STOREK((t + 1) & 1);
        if (t < ntl) AT_STOREV(t & 1);
        if (t + 2 < ntl) AT_LOADK(t + 2);
        if (t + 1 < ntl) AT_LOADV(t + 1);
        if (t >= 1 && act_prev) {
            const LAS unsigned char* Vb = lds + VOFF + ((t - 1) & 1) * VBUF;
#pragma unroll
            for (int kb = 0; kb < 2; ++kb)
#pragma unroll
                for (int s = 0; s < 2; ++s) {
                    const LAS unsigned char* vb = Vb + vlane + (kb * 32 + 16 * s) * VP * 2;
#pragma unroll
                    for (int db = 0; db < 2; ++db) {
                        const s16x4 lo = __builtin_bit_cast(s16x4, __builtin_amdgcn_ds_read_tr16_b64_v4i16((LAS s16x4*)(vb + db * 64)));
                        const s16x4 hi = __builtin_bit_cast(s16x4, __builtin_amdgcn_ds_read_tr16_b64_v4i16((LAS s16x4*)(vb + db * 64 + 8 * VP * 2)));
                        const bf16x8 vf = __builtin_shufflevector(lo, hi, 0, 1, 2, 3, 4, 5, 6, 7);
                        if (db == 0) o0 = __builtin_amdgcn_mfma_f32_32x32x16_bf16(vf, pa[kb][s], o0, 0, 0, 0);
                        else o1 = __builtin_amdgcn_mfma_f32_32x32x16_bf16(vf, pa[kb][s], o1, 0, 0, 0);
                    }
                }
        }
        act = false;
        if (t < ntl) {
            act = true;
            if (band && t >= 4) { kt0 = (t_lo2 + t - 4) * 64; act = (kt0 + 63 >= qw - 128) && (kt0 <= qw + 31 + 128); }
            if (act) {
                const LAS unsigned char* Kb = lds + (t & 1) * KBUF;
#pragma unroll
                for (int d0 = 0; d0 < ND; ++d0) {
                    const bf16x8 k0 = *(const LAS bf16x8*)(Kb + (r * KP + 16 * d0 + 8 * h) * 2);
                    const bf16x8 k1 = *(const LAS bf16x8*)(Kb + ((32 + r) * KP + 16 * d0 + 8 * h) * 2);
                    if (d0 == 0) { p0 = __builtin_amdgcn_mfma_f32_32x32x16_bf16(k0, qf[d0], negm, 0, 0, 0); p1 = __builtin_amdgcn_mfma_f32_32x32x16_bf16(k1, qf[d0], negm, 0, 0, 0); }
                    else { p0 = __builtin_amdgcn_mfma_f32_32x32x16_bf16(k0, qf[d0], p0, 0, 0, 0); p1 = __builtin_amdgcn_mfma_f32_32x32x16_bf16(k1, qf[d0], p1, 0, 0, 0); }
                }
            }
        }
        __syncthreads();
        if (act) {
            if (band && t >= 4) { const int qpos = qw + r;
#pragma unroll
                for (int i = 0; i < 16; ++i) { const int kp = kt0 + crow(i, h); int d = qpos - kp; d = d < 0 ? -d : d; if (d > 128) p0[i] = -1e30f; int d2 = qpos - kp - 32; d2 = d2 < 0 ? -d2 : d2; if (d2 > 128) p1[i] = -1e30f; } }
            f32x16 e0, e1; unsigned um = 0u;
#pragma unroll
            for (int i = 0; i < 16; ++i) { e0[i] = __builtin_amdgcn_exp2f(p0[i]); e1[i] = __builtin_amdgcn_exp2f(p1[i]); const unsigned a = __float_as_uint(e0[i]), b = __float_as_uint(e1[i]); um = um > a ? um : a; um = um > b ? um : b; }
            { auto rr = __builtin_amdgcn_permlane32_swap(um, um, false, false); um = rr[0] > rr[1] ? rr[0] : rr[1]; }
            if (!started || __any(um > 0x43800000u)) {
                float mx = fmaxf(p0[0], p1[0]);
#pragma unroll
                for (int i = 1; i < 16; ++i) mx = fmaxf(mx, fmaxf(p0[i], p1[i]));
                { auto rr = __builtin_amdgcn_permlane32_swap(__float_as_uint(mx), __float_as_uint(mx), false, false); mx = fmaxf(__uint_as_float(rr[0]), __uint_as_float(rr[1])); }
                float alpha = 1.f;
                if (started || has_sink) { mx = fmaxf(mx, 0.f); alpha = __builtin_amdgcn_exp2f(-mx); }
                m_run += mx; l_run *= alpha;
#pragma unroll
                for (int i = 0; i < 16; ++i) { o0[i] *= alpha; o1[i] *= alpha; e0[i] = __builtin_amdgcn_exp2f(p0[i] - mx); e1[i] = __builtin_amdgcn_exp2f(p1[i] - mx); negm[i] = -m_run; }
                started = true;
            }
            float sum = 0.f;
#pragma unroll
            for (int i = 0; i < 16; ++i) { sum += e0[i] + e1[i]; p0[i] = e0[i]; p1[i] = e1[i]; }
            l_run += sum;
#pragma unroll
            for (int s = 0; s < 2; ++s) { u32x4 w; w.x = cvtpk(p0[8 * s], p0[8 * s + 1]); w.y = cvtpk(p0[8 * s + 2], p0[8 * s + 3]); w.z = cvtpk(p0[8 * s + 4], p0[8 * s + 5]); w.w = cvtpk(p0[8 * s + 6], p0[8 * s + 7]); pa[0][s] = __builtin_bit_cast(bf16x8, w);
                u32x4 w2; w2.x = cvtpk(p1[8 * s], p1[8 * s + 1]); w2.y = cvtpk(p1[8 * s + 2], p1[8 * s + 3]); w2.z = cvtpk(p1[8 * s + 4], p1[8 * s + 5]); w2.w = cvtpk(p1[8 * s + 6], p1[8 * s + 7]); pa[1][s] = __builtin_bit_cast(bf16x8, w2); }
        }
        act_prev = act;
        __syncthreads();
    }
    if (grp == 0) __syncthreads();
#undef AT_LOADK
#undef AT_LOADV
#undef AT_STOREK
#undef AT_STOREV
    float lt = l_run; { auto rr = __builtin_amdgcn_permlane32_swap(__float_as_uint(lt), __float_as_uint(lt), false, false); lt = __uint_as_float(rr[0]) + __uint_as_float(rr[1]); }
    const float inv = 1.f / lt;
    LAS unsigned char* stg = lds + 51200 + wid * 4608;
#pragma unroll
    for (int g = 0; g < 4; ++g) {
        u32x2 w; w.x = cvtpk(o0[4 * g] * inv, o0[4 * g + 1] * inv); w.y = cvtpk(o0[4 * g + 2] * inv, o0[4 * g + 3] * inv); *(LAS u32x2*)(stg + r * 144 + (8 * g + 4 * h) * 2) = w;
        u32x2 w2; w2.x = cvtpk(o1[4 * g] * inv, o1[4 * g + 1] * inv); w2.y = cvtpk(o1[4 * g + 2] * inv, o1[4 * g + 3] * inv); *(LAS u32x2*)(stg + r * 144 + (32 + 8 * g + 4 * h) * 2) = w2;
    }
    asm volatile("s_waitcnt lgkmcnt(0)" ::: "memory");
    bf16_t* ow = Orow0 + (size_t)(wid * 32) * opitch;
#pragma unroll
    for (int i = 0; i < 4; ++i) { const int c = i * 64 + lane, row = c >> 3, ch = c & 7;
        const u32x4 v = *(const LAS u32x4*)(stg + row * 144 + ch * 16); *(u32x4*)(ow + (size_t)row * opitch + ch * 8) = v; }
}


#define XB_TMO      128
#define XB_XCNT(j)  (256  + 64 * (j))
#define XB_XSUB(j)  (1280 + 64 * (j))
#define XB_XGEN(j)  (2304 + 64 * (j))
#define XB_TOP      3328
#define XB_TOPGEN   3392
#define XCD_BAR_WORDS 3456
#define XB_SPIN_CAP (1u << 18)
DI unsigned xb_ld(unsigned* p)              { return __hip_atomic_load(p, __ATOMIC_RELAXED, __HIP_MEMORY_SCOPE_AGENT); }
DI unsigned xb_add(unsigned* p, unsigned v) { return __hip_atomic_fetch_add(p, v, __ATOMIC_RELAXED, __HIP_MEMORY_SCOPE_AGENT); }
DI unsigned xb_xcc_id() { return (unsigned)__builtin_amdgcn_s_getreg((3 << 11) | 20) & 0xFu; }
#define XB_SPIN(cond, bar) do { unsigned _sp = 0; while (cond) { __builtin_amdgcn_s_sleep(1); \
    if ((++_sp & 255u) == 0u) { if (xb_ld(&(bar)[XB_TMO])) break; if (_sp > XB_SPIN_CAP) { atomicAdd(&(bar)[XB_TMO], 1u); break; } } } } while (0)
struct XcdBarrier { unsigned* bar; unsigned x; volatile LAS unsigned* st; };
DI void xcd_barrier_complete(unsigned* bar, unsigned x, unsigned& nloc, unsigned& nx) {
    const unsigned G = gridDim.x * gridDim.y * gridDim.z;
    unsigned sum, cnt, mine, sp = 0u;
    for (;;) {
        sum = 0u; cnt = 0u; mine = 0u;
#pragma unroll
        for (unsigned j = 0; j < 16; ++j) { const unsigned c = xb_ld(&bar[XB_XCNT(j)]); sum += c; cnt += (c > 0u) ? 1u : 0u; mine = (j == x) ? c : mine; }
        if (sum == G) break;
        __builtin_amdgcn_s_sleep(1);
        if ((++sp & 255u) == 0u) { if (xb_ld(&bar[XB_TMO])) break; if (sp > XB_SPIN_CAP) { atomicAdd(&bar[XB_TMO], 1u); break; } }
    }
    nloc = mine > 0u ? mine : 1u; nx = cnt > 0u ? cnt : 1u;
}
DI void xcd_barrier(const XcdBarrier& b) {
    asm volatile("s_waitcnt vmcnt(0)" ::: "memory");
    __syncthreads();
    if (threadIdx.x == 0) {
        unsigned* bar = b.bar;
        __builtin_amdgcn_s_waitcnt(0);
        unsigned nloc = b.st[0], nx = b.st[1];
        if (nloc == 0u) { xcd_barrier_complete(bar, b.x, nloc, nx); b.st[0] = nloc; b.st[1] = nx; }
        const unsigned old = xb_add(&bar[XB_XSUB(b.x)], 1u);
        const unsigned gen = old / nloc;
        if (old + 1u == (gen + 1u) * nloc) {
            __builtin_amdgcn_fence(__ATOMIC_RELEASE, "agent");
            asm volatile("s_waitcnt vmcnt(0)" ::: "memory");
            const unsigned og = xb_add(&bar[XB_TOP], 1u);
            const unsigned tg = og / nx;
            if (og + 1u == (tg + 1u) * nx) xb_add(&bar[XB_TOPGEN], 1u);
            else XB_SPIN(xb_ld(&bar[XB_TOPGEN]) == tg, bar);
            __builtin_amdgcn_fence(__ATOMIC_ACQUIRE, "agent");
            xb_add(&bar[XB_XGEN(b.x)], 1u);
            asm volatile("s_waitcnt vmcnt(0)" ::: "memory");
        } else {
            XB_SPIN(xb_ld(&bar[XB_XGEN(b.x)]) == gen, bar);
            __builtin_amdgcn_fence(__ATOMIC_ACQUIRE, "agent");
            asm volatile("s_waitcnt vmcnt(0)" ::: "memory");
        }
    }
    __syncthreads();
}
constexpr int XB_LDS_OFF = 131072 + 64;

struct Args { const float* in[27]; float* out; unsigned char* ws; };
enum { I_X = 0, I_C, I_CTX, I_CCTX, I_MODW, I_MODB, I_NPRE, I_NPOST, I_W13, I_W2, I_AWIN, I_QNORM, I_WUQ, I_KVNORM, I_WUKV, I_SINK, I_AWOUT, I_S5WIN, I_LRE, I_LIM, I_BRE, I_BIM, I_CRE, I_CIM, I_LSTEP, I_S5D, I_WGLU };

DI void transpose_item(const float* W, int N, bf16_t* WT, int ldk, int koff, int drow0, LAS float* scr, int k0, int n0, int lane) {
#pragma unroll 8
    for (int i = 0; i < 32; ++i) { const int kk = 2 * i + (lane >> 5); scr[kk * 33 + (lane & 31)] = W[(size_t)(k0 + kk) * N + n0 + (lane & 31)]; }
    asm volatile("s_waitcnt lgkmcnt(0)" ::: "memory");
    const int c = lane & 7;
#pragma unroll
    for (int j = 0; j < 4; ++j) { const int n = (lane >> 3) + 8 * j; const LAS float* s = scr + (8 * c) * 33 + n;
        u32x4 o; o.x = cvtpk(s[0 * 33], s[1 * 33]); o.y = cvtpk(s[2 * 33], s[3 * 33]); o.z = cvtpk(s[4 * 33], s[5 * 33]); o.w = cvtpk(s[6 * 33], s[7 * 33]);
        *(u32x4*)(WT + (size_t)(drow0 + n) * ldk + koff + k0 + 8 * c) = o; }
    asm volatile("s_waitcnt lgkmcnt(0)" ::: "memory");
}
DI int pairmap(int n0, int split) { const int jj = n0 < split ? n0 : n0 - split; return (jj >> 7) * 256 + (n0 < split ? 0 : 128) + (jj & 127); }

struct RowOp {
    const void* hin_lat; const void* hin_ctx; bool hin_bf16; void* hout_lat; void* hout_ctx; bool hout_bf16;
    const bf16_t* Y; const float* g_post; const float* modg; int gate_idx; float coef;
    const float* g_pre; const float* modp; int shift_idx, scale_idx; bf16_t* A; int nrows;
};
DI void unpack8(const u32x4 w, float* v) {
#pragma unroll
    for (int e = 0; e < 4; ++e) { v[2 * e] = __builtin_bit_cast(float, w[e] << 16); v[2 * e + 1] = __builtin_bit_cast(float, w[e] & 0xffff0000u); }
}
DI void ld16(const float* v, int lane, float* d) {
    const f32x4* p = (const f32x4*)v;
#pragma unroll
    for (int j = 0; j < 2; ++j)
#pragma unroll
        for (int q = 0; q < 2; ++q) { const f32x4 x = p[2 * lane + q + 128 * j];
#pragma unroll
            for (int e = 0; e < 4; ++e) d[8 * j + 4 * q + e] = x[e]; }
}
DI void row_phase(const RowOp& o, int gw, int ngw, int lane) {
    const int chunk = (o.nrows + ngw - 1) / ngw, rbeg = gw * chunk, rend = (rbeg + chunk) < o.nrows ? (rbeg + chunk) : o.nrows;
    float gpo[16], gpr[16], gat[16], shf[16], scl[16]; int cur = -1;
#pragma unroll
    for (int e = 0; e < 16; ++e) { gpo[e] = 0.f; gpr[e] = 0.f; gat[e] = 0.f; shf[e] = 0.f; scl[e] = 0.f; }
    if (o.Y) ld16(o.g_post, lane, gpo);
    if (o.g_pre) ld16(o.g_pre, lane, gpr);
    for (int row0 = rbeg; row0 < rend; row0 += 4) {
        float hv[4][16], yv[4][16]; bool ok[4]; int rows[4];
#pragma unroll
        for (int u = 0; u < 4; ++u) { const int row = row0 + u; rows[u] = row; ok[u] = row < rend;
            if (ok[u]) { const size_t roff = row < TL ? (size_t)row * D : (size_t)(row - TL) * D;
                if (o.hin_bf16) { const u32x4* hp = (const u32x4*)((const bf16_t*)(row < TL ? o.hin_lat : o.hin_ctx) + roff);
#pragma unroll
                    for (int j = 0; j < 2; ++j) unpack8(hp[lane + 64 * j], &hv[u][8 * j]); }
                else { const f32x4* hp = (const f32x4*)((const float*)(row < TL ? o.hin_lat : o.hin_ctx) + roff);
#pragma unroll
                    for (int j = 0; j < 2; ++j) { const f32x4 a = hp[2 * lane + 128 * j], b = hp[2 * lane + 1 + 128 * j];
#pragma unroll
                        for (int e = 0; e < 4; ++e) { hv[u][8 * j + e] = a[e]; hv[u][8 * j + 4 + e] = b[e]; } } }
                if (o.Y) { const u32x4* yp = (const u32x4*)(o.Y + (size_t)row * D);
#pragma unroll
                    for (int j = 0; j < 2; ++j) unpack8(yp[lane + 64 * j], &yv[u][8 * j]); } } }
#pragma unroll
        for (int u = 0; u < 4; ++u) if (ok[u]) { const int row = rows[u]; const int mrow = row < TL ? (row >> 13) : 8; const size_t roff = row < TL ? (size_t)row * D : (size_t)(row - TL) * D;
            if (mrow != cur) { cur = mrow;
                if (o.Y) { ld16(o.modg + (size_t)mrow * 9216 + o.gate_idx * D, lane, gat);
#pragma unroll
                    for (int e = 0; e < 16; ++e) gat[e] *= o.coef; }
                if (o.g_pre) { ld16(o.modp + (size_t)mrow * 9216 + o.shift_idx * D, lane, shf); ld16(o.modp + (size_t)mrow * 9216 + o.scale_idx * D, lane, scl);
#pragma unroll
                    for (int e = 0; e < 16; ++e) scl[e] += 1.0f; } }
            if (o.Y) {
                float ss = 0.f;
#pragma unroll
                for (int e = 0; e < 16; ++e) ss += yv[u][e] * yv[u][e];
                const float rstd = 1.0f / sqrtf(wave_sum(ss) * (1.f / D) + EPSV);
#pragma unroll
                for (int e = 0; e < 16; ++e) hv[u][e] += gat[e] * (yv[u][e] * rstd * gpo[e]);
                if (o.hout_bf16) { u32x4* op = (u32x4*)((bf16_t*)(row < TL ? o.hout_lat : o.hout_ctx) + roff);
#pragma unroll
                    for (int j = 0; j < 2; ++j) { u32x4 w;
#pragma unroll
                        for (int e = 0; e < 4; ++e) w[e] = cvtpk(hv[u][8 * j + 2 * e], hv[u][8 * j + 2 * e + 1]);
                        op[lane + 64 * j] = w; unpack8(w, &hv[u][8 * j]); } }
                else { f32x4* op = (f32x4*)((float*)(row < TL ? o.hout_lat : o.hout_ctx) + roff);
#pragma unroll
                    for (int j = 0; j < 2; ++j) { op[2 * lane + 128 * j] = (f32x4){hv[u][8 * j], hv[u][8 * j + 1], hv[u][8 * j + 2], hv[u][8 * j + 3]}; op[2 * lane + 1 + 128 * j] = (f32x4){hv[u][8 * j + 4], hv[u][8 * j + 5], hv[u][8 * j + 6], hv[u][8 * j + 7]}; } }
            }
            if (o.g_pre) {
                float ss = 0.f;
#pragma unroll
                for (int e = 0; e < 16; ++e) ss += hv[u][e] * hv[u][e];
                const float rstd = 1.0f / sqrtf(wave_sum(ss) * (1.f / D) + EPSV);
                u32x4* ap = (u32x4*)(o.A + (size_t)row * D);
#pragma unroll
                for (int j = 0; j < 2; ++j) { u32x4 w;
#pragma unroll
                    for (int e = 0; e < 4; ++e) w[e] = cvtpk((hv[u][8 * j + 2 * e] * rstd * gpr[8 * j + 2 * e]) * scl[8 * j + 2 * e] + shf[8 * j + 2 * e], (hv[u][8 * j + 2 * e + 1] * rstd * gpr[8 * j + 2 * e + 1]) * scl[8 * j + 2 * e + 1] + shf[8 * j + 2 * e + 1]);
                    ap[lane + 64 * j] = w; }
            }
        }
    }
}

#define KSETUP \
    const int G = gridDim.x, bx = blockIdx.x; \
    const int ngw = G * 8, ngt = G * 512; \
    const int vcu = (G % 8 == 0) ? (bx % 8) * (G / 8) + bx / 8 : bx; \
    GAS unsigned char* wsg_ = (GAS unsigned char*)args.ws; asm volatile("" : "+s"(wsg_)); unsigned char* ws = (unsigned char*)wsg_; \
    float* MOD = (float*)(ws + WS_MOD); float* ROPE = (float*)(ws + WS_ROPE); \
    float* ABAR = (float*)(ws + WS_ABAR); float* BBAR = (float*)(ws + WS_BBAR); float* POW = (float*)(ws + WS_POW); float* KTAB = (float*)(ws + WS_KTAB); float* SCTX = (float*)(ws + WS_SCTX); \
    bf16_t* W13T = (bf16_t*)(ws + WS_W13T); bf16_t* W2T = (bf16_t*)(ws + WS_W2T); bf16_t* WINT = (bf16_t*)(ws + WS_WINT); bf16_t* WUT = (bf16_t*)(ws + WS_WUT); \
    bf16_t* WOUTT = (bf16_t*)(ws + WS_WOUTT); bf16_t* S5INT = (bf16_t*)(ws + WS_S5INT); bf16_t* GLUT = (bf16_t*)(ws + WS_GLUT); \
    bf16_t* HCTX = (bf16_t*)(ws + WS_HCTX); bf16_t* Ab = (bf16_t*)(ws + WS_A); bf16_t* Yb = (bf16_t*)(ws + WS_Y); bf16_t* HB = (bf16_t*)(ws + WS_HB); \
    bf16_t* Ub = (bf16_t*)(ws + WS_U); bf16_t* PROJ = (bf16_t*)(ws + WS_PROJ); bf16_t* CN = (bf16_t*)(ws + WS_CN); bf16_t* QKV = (bf16_t*)(ws + WS_QKV); \
    bf16_t* XE = (bf16_t*)(ws + WS_XE); float* UC = (float*)(ws + WS_UC); float* Eb = (float*)(ws + WS_E); bf16_t* BMm = (bf16_t*)(ws + WS_BM); bf16_t* BSm = (bf16_t*)(ws + WS_BS); \
    float* OUT = gl(args.out); \
    const float* MOD0 = MOD; const float* MOD1 = MOD + 9 * 9216; (void)MOD0; (void)MOD1;

#define IN(i) gl(args.in[i])
#define GSYNC() do { for (int rs_ = 0; rs_ < PROBE_SYNC; ++rs_) { GAS unsigned char* wb_ = (GAS unsigned char*)args.ws; asm volatile("" : "+s"(wb_)); XcdBarrier xb_; xb_.bar = (unsigned*)(unsigned char*)wb_; xb_.x = xb_xcc_id(); xb_.st = (volatile LAS unsigned*)(lds + XB_LDS_OFF); xcd_barrier(xb_); } } while (0)
#define TIDS int tid = threadIdx.x; asm volatile("" : "+v"(tid)); const int lane = tid & 63, wave = __builtin_amdgcn_readfirstlane(tid >> 6); const int gw = bx * 8 + wave, gt = bx * 512 + tid; (void)lane; (void)gw; (void)gt;

DI void prologue_phase(const Args& args, LAS unsigned char* lds) {
    KSETUP
    TIDS
    {
        LAS float* sS = (LAS float*)lds;
        LAS float* sR = (LAS float*)(lds + 36864);
        for (int i = tid; i < 9 * 1024; i += 512) { const int r = i >> 10, k = i & 1023; const float c = r < 8 ? IN(I_C)[r * 1024 + k] : IN(I_CCTX)[k]; sS[i] = c * sigm(c); }
        __syncthreads();
        for (int u = bx; u < 288; u += G) {
            const int l = u / 144, n = (u % 144) * 64 + lane; const float* W = IN(I_MODW) + (size_t)l * 1024 * 9216 + n;
            float acc[9];
#pragma unroll
            for (int r = 0; r < 9; ++r) acc[r] = 0.f;
#pragma unroll 4
            for (int k = wave * 128; k < wave * 128 + 128; ++k) { const float w = W[(size_t)k * 9216];
#pragma unroll
                for (int r = 0; r < 9; ++r) acc[r] += sS[r * 1024 + k] * w; }
#pragma unroll
            for (int r = 0; r < 9; ++r) sR[(wave * 9 + r) * 64 + lane] = acc[r];
            __syncthreads();
            for (int i = tid; i < 9 * 64; i += 512) { const int r = i >> 6, c = i & 63; float s = 0.f;
#pragma unroll
                for (int w = 0; w < 8; ++w) s += sR[(w * 9 + r) * 64 + c];
                const int nn = (u % 144) * 64 + c; MOD[((size_t)l * 9 + r) * 9216 + nn] = s + IN(I_MODB)[l * 9216 + nn]; }
            __syncthreads();
        }
        LAS float* scr = (LAS float*)(lds + wave * 16384);
        constexpr int I13 = 16 * 176, I2 = 44 * 32, IIN = 16 * 37, IUQ = 4 * 24, IUKV = 2 * 32, ISQ = 16 * 32, IGLU = 16 * 64;
        constexpr int NIT = 4 * I13 + 4 * I2 + IIN + IUQ + IUKV + ISQ + ISQ + IGLU;
        for (int it = gw; it < NIT; it += ngw) {
            int r = it;
            if (r < 4 * I13) { const int w = r / I13; r %= I13; const int kb = r / 176, nb = r % 176; transpose_item(IN(I_W13) + (size_t)w * 1024 * 5632, 5632, W13T + (size_t)w * 5632 * 1024, 1024, 0, pairmap(nb * 32, 2816), scr, kb * 64, nb * 32, lane); continue; } r -= 4 * I13;
            if (r < 4 * I2) { const int w = r / I2; r %= I2; const int kb = r / 32, nb = r % 32; transpose_item(IN(I_W2) + (size_t)w * 2816 * 1024, 1024, W2T + (size_t)w * 1024 * 2816, 2816, 0, nb * 32, scr, kb * 64, nb * 32, lane); continue; } r -= 4 * I2;
            if (r < IIN) { const int kb = r / 37, nb = r % 37; transpose_item(IN(I_AWIN), 1184, WINT, 1024, 0, nb * 32, scr, kb * 64, nb * 32, lane); continue; } r -= IIN;
            if (r < IUQ) { const int kb = r / 24, nb = r % 24; transpose_item(IN(I_WUQ), 768, WUT, 384, 0, nb * 32, scr, kb * 64, nb * 32, lane); continue; } r -= IUQ;
            if (r < IUKV) { const int kb = r / 32, nb = r % 32; transpose_item(IN(I_WUKV), 1024, WUT, 384, 256, 768 + nb * 32, scr, kb * 64, nb * 32, lane); continue; } r -= IUKV;
            if (r < ISQ) { const int kb = r / 32, nb = r % 32; transpose_item(IN(I_AWOUT), 1024, WOUTT, 1024, 0, nb * 32, scr, kb * 64, nb * 32, lane); continue; } r -= ISQ;
            if (r < ISQ) { const int kb = r / 32, nb = r % 32; transpose_item(IN(I_S5WIN), 1024, S5INT, 1024, 0, nb * 32, scr, kb * 64, nb * 32, lane); continue; } r -= ISQ;
            { const int kb = r / 64, nb = r % 64; transpose_item(IN(I_WGLU), 2048, GLUT, 1024, 0, pairmap(nb * 32, 1024), scr, kb * 64, nb * 32, lane); }
        }
        const u32x4 z4 = (u32x4){0u, 0u, 0u, 0u};
        for (int i = gt; i < 96 * 128; i += ngt) *(u32x4*)(WINT + (size_t)(1184 + i / 128) * 1024 + (i % 128) * 8) = z4;
        for (int i = gt; i < 768 * 16; i += ngt) *(u32x4*)(WUT + (size_t)(i / 16) * 384 + 256 + (i % 16) * 8) = z4;
        for (int i = gt; i < 1024 * 32; i += ngt) *(u32x4*)(WUT + (size_t)(768 + i / 32) * 384 + (i % 32) * 8) = z4;
        for (int i = gt; i < 128 * 24; i += ngt) { const int p = i / 24, f = i % 24;
            if (f < 8) { const float inv = exp2f(-13.287712379549449f * (2.f * f / 16.f)); float s, c; sincos_rad_d((double)((float)p * inv), s, c); ROPE[p * 8 + f] = c; ROPE[1024 + p * 8 + f] = s; }
            else { const int ff = f - 8; const float inv = exp2f(-13.287712379549449f * (2.f * ff / 32.f)); float s, c; sincos_rad_d((double)((float)p * inv), s, c); ROPE[2048 + p * 16 + ff] = c; ROPE[4096 + p * 16 + ff] = s; } }
        for (int i = gt; i < 2 * 64 * 64; i += ngt) { const int dir = i >> 12, g = (i >> 6) & 63, p = i & 63;
            const float lre = fminf(IN(I_LRE)[i], -1e-4f), lim = IN(I_LIM)[i], dt = __expf(IN(I_LSTEP)[dir * 64 + g]);
            float* pw = POW + (size_t)i * 130;
            for (int d = 0; d <= 64; ++d) { const float mag = __expf(lre * dt * (float)d); float s, c; sincos_rad_d((double)lim * (double)dt * (double)d, s, c); pw[2 * d] = mag * c; pw[2 * d + 1] = mag * s; }
            const float are = pw[2], aim = pw[3]; ABAR[2 * i] = are; ABAR[2 * i + 1] = aim;
            const float den = lre * lre + lim * lim, fre = ((are - 1.f) * lre + aim * lim) / den, fim = (aim * lre - (are - 1.f) * lim) / den;
            for (int hh = 0; hh < 16; ++hh) { const float br = IN(I_BRE)[(size_t)i * 16 + hh], bi = IN(I_BIM)[(size_t)i * 16 + hh]; BBAR[((size_t)i * 16 + hh) * 2] = fre * br - fim * bi; BBAR[((size_t)i * 16 + hh) * 2 + 1] = fre * bi + fim * br; } }
    }

}
#define RUN_GEMM(EPI_T, epi, Aptr, Btptr, M_, N_, K_, lda_, ldb_, mtg_, strB_) do { pg8::Gemm g_{(Aptr), (Btptr), (M_), (N_), (K_), (lda_), (ldb_), (mtg_), (size_t)(strB_)}; pg8::StaticOrder S_; S_.init((M_), (N_), G, bx); \
        pg8::gemm_phase<EPI_T>(lds, g_, S_, (epi)); } while (0)
    constexpr int NOGRP = 1 << 30;


template <int l>
DI void layer_phase(const Args& args, LAS unsigned char* lds, cg::grid_group& grid) {
    KSETUP

        const float* MODL = l == 0 ? MOD0 : MOD1;
        const float* npre = IN(I_NPRE) + l * 3 * D; const float* npost = IN(I_NPOST) + l * 3 * D;
        if (l == 0) {
            TIDS
            for (int rep_ = 0; rep_ < PROBE_MISC; ++rep_) for (int i = gt; i < 64 * 2 * 64 * 16; i += ngt) { const int hh = i & 15, d = (i >> 4) & 63, dir = (i >> 10) & 1, g = i >> 11; const int base = (dir * 64 + g) * 64;
                const float* cr = IN(I_CRE) + ((size_t)(dir * 64 + g) * 16 + hh) * 64; const float* ci = IN(I_CIM) + ((size_t)(dir * 64 + g) * 16 + hh) * 64; float acc[16];
#pragma unroll
                for (int q = 0; q < 16; ++q) acc[q] = 0.f;
#pragma unroll 4
                for (int p = 0; p < 64; ++p) { const float pr = POW[(size_t)(base + p) * 130 + 2 * d], pi = POW[(size_t)(base + p) * 130 + 2 * d + 1]; const float c_r = cr[p], c_i = ci[p];
                    const float al = c_r * pr - c_i * pi, be = c_r * pi + c_i * pr; const f32x4* bb = (const f32x4*)(BBAR + (size_t)(base + p) * 32);
#pragma unroll
                    for (int q = 0; q < 8; ++q) { const f32x4 v = bb[q]; acc[2 * q] += v.x * al - v.y * be; acc[2 * q + 1] += v.z * al - v.w * be; } }
                f32x4* o = (f32x4*)(KTAB + ((((size_t)g * 2 + dir) * 64 + d) * 16 + hh) * 16);
#pragma unroll
                for (int q = 0; q < 4; ++q) o[q] = (f32x4){acc[4 * q], acc[4 * q + 1], acc[4 * q + 2], acc[4 * q + 3]}; }
            RowOp o{IN(I_X), IN(I_CTX), false, nullptr, nullptr, true, nullptr, nullptr, nullptr, 0, 0.f, npre, MODL, 0, 1, Ab, TA};
            row_phase(o, gw, ngw, lane);
            GSYNC();
        }
        for (int rep_ = 0; rep_ < PROBE_G1; ++rep_) { pg8::EpiSwiglu e{Ub}; RUN_GEMM(pg8::EpiSwiglu, e, Ab, W13T + (size_t)(l * 2) * 5632 * 1024, TA, 5632, 1024, 1024, 1024, NOGRP, 0); }
        GSYNC();
        for (int rep_ = 0; rep_ < PROBE_G2; ++rep_) { pg8::EpiBf16 e{Yb, D}; RUN_GEMM(pg8::EpiBf16, e, Ub, W2T + (size_t)(l * 2) * 1024 * 2816, TA, 1024, 2816, 2816, 2816, NOGRP, 0); }
        GSYNC();
        {
            TIDS
            RowOp o{l == 0 ? (const void*)IN(I_X) : (const void*)HB, l == 0 ? (const void*)IN(I_CTX) : (const void*)HCTX, l != 0, HB, HCTX, true, Yb, npost, MODL, 2, 0.5f, npre + D, MODL, 3, 4, Ab, TA};
            row_phase(o, gw, ngw, lane);
        }
        GSYNC();
        if (l == 0) {
            { pg8::EpiBf16 e{PROJ, PROJ_N}; RUN_GEMM(pg8::EpiBf16, e, Ab, WINT, TA, PROJ_N, 1024, 1024, 1024, NOGRP, 0); }
            GSYNC();
            { TIDS
            for (int row0 = gw; row0 < TA; row0 += 2 * ngw) {
                u32x2 wq[2]; unsigned wk[2]; float ka[2], kb[2], sa[2], sb[2]; bool ok[2];
#pragma unroll
                for (int u = 0; u < 2; ++u) { const int row = row0 + u * ngw; ok[u] = row < TA; ka[u] = kb[u] = sa[u] = sb[u] = 0.f; wq[u] = (u32x2){0u, 0u}; wk[u] = 0u;
                    if (ok[u]) { const bf16_t* pr = PROJ + (size_t)row * PROJ_N; wq[u] = ((const u32x2*)pr)[lane]; wk[u] = ((const unsigned*)(pr + 256))[lane];
                        if (row < TL) { if (lane < 16) { ka[u] = bf2f(pr[384 + lane]); kb[u] = bf2f(pr[400 + lane]); }
                            const bf16_t* q = pr + 928 + (lane >> 5) * 64; sa[u] = bf2f(q[lane & 31]); sb[u] = bf2f(q[32 + (lane & 31)]); } } }
#pragma unroll
                for (int u = 0; u < 2; ++u) if (ok[u]) { const int row = row0 + u * ngw; bf16_t* pr = PROJ + (size_t)row * PROJ_N;
                    { const u32x2 w = wq[u]; float v0 = bf2f(w.x & 0xffff), v1 = bf2f(w.x >> 16), v2 = bf2f(w.y & 0xffff), v3 = bf2f(w.y >> 16);
                      const float rstd = 1.0f / sqrtf(wave_sum(v0 * v0 + v1 * v1 + v2 * v2 + v3 * v3) * (1.f / 256.f) + EPSV); const f32x4 g = ((const f32x4*)IN(I_QNORM))[lane];
                      u32x2 o; o.x = cvtpk(v0 * rstd * g.x, v1 * rstd * g.y); o.y = cvtpk(v2 * rstd * g.z, v3 * rstd * g.w); ((u32x2*)(CN + (size_t)row * CN_N))[lane] = o; }
                    { const unsigned w = wk[u]; float v0 = bf2f(w & 0xffff), v1 = bf2f(w >> 16);
                      const float rstd = 1.0f / sqrtf(wave_sum(v0 * v0 + v1 * v1) * (1.f / 128.f) + EPSV); const float g0 = IN(I_KVNORM)[2 * lane], g1 = IN(I_KVNORM)[2 * lane + 1];
                      ((unsigned*)(CN + (size_t)row * CN_N + 256))[lane] = cvtpk(v0 * rstd * g0, v1 * rstd * g1); }
                    if (row < TL) { const int pos = row & 8191, rr = pos >> 6, cc = pos & 63;
                        if (lane < 16) { const int i = lane, p = i < 8 ? rr : cc, f = i & 7; const float c = ROPE[p * 8 + f], sn = ROPE[1024 + p * 8 + f]; const float a_ = ka[u], b_ = kb[u];
                            pr[384 + i] = (bf16_t)f2bf(a_ * c - b_ * sn); pr[400 + i] = (bf16_t)f2bf(a_ * sn + b_ * c); }
                        { const int hd = lane >> 5, i = lane & 31, p = i < 16 ? rr : cc, f = i & 15; const float c = ROPE[2048 + p * 16 + f], sn = ROPE[4096 + p * 16 + f]; bf16_t* q = pr + 928 + hd * 64;
                            const float a_ = sa[u], b_ = sb[u]; q[i] = (bf16_t)f2bf(a_ * c - b_ * sn); q[32 + i] = (bf16_t)f2bf(a_ * sn + b_ * c); } } }
            } }
            GSYNC();
            {
                pg8::EpiBf16 eq{QKV, QKV_N}; RUN_GEMM(pg8::EpiBf16, eq, CN, WUT, TA, 768, 256, CN_N, CN_N, NOGRP, 0);
                pg8::EpiBf16 ek{QKV + 768, QKV_N}; RUN_GEMM(pg8::EpiBf16, ek, CN + 256, WUT + (size_t)768 * CN_N + 256, TA, 1024, 128, CN_N, CN_N, NOGRP, 0); }
            GSYNC();
            {
                const float scA = 0.10206207261596577f * LOG2E, scB = 0.125f * LOG2E;
                for (int rep_ = 0; rep_ < PROBE_ATT; ++rep_) {
                for (int u = vcu; u < 2048; u += G) { const int bh = u >> 5, qb = u & 31, b = bh >> 3, hd = bh & 7; const size_t lrow = (size_t)b * SEQ, crow_ = (size_t)TL + b * CTXN;
                    attn_unit<96>(lds, QKV + (lrow + qb * 256) * QKV_N + hd * 96, QKV_N, QKV + crow_ * QKV_N + 768 + hd * 128, QKV + lrow * QKV_N + 768 + hd * 128, QKV_N,
                                  PROJ + crow_ * PROJ_N + 384, PROJ + lrow * PROJ_N + 384, PROJ_N, QKV + crow_ * QKV_N + 832 + hd * 128, QKV + lrow * QKV_N + 832 + hd * 128, QKV_N,
                                  Ab + (lrow + qb * 256) * D + hd * 64, D, 0, 128, false, qb * 256, scA, false, 0.f, 1, ROPE); }
                for (int u = vcu; u < 2048; u += G) { const int bh = u >> 5, qb = u & 31, b = bh >> 3, qh = bh & 7; const size_t lrow = (size_t)b * SEQ, crow_ = (size_t)TL + b * CTXN;
                    const int lo = (4 * qb - 2) < 0 ? 0 : 4 * qb - 2, hi = (4 * qb + 6) > 128 ? 128 : 4 * qb + 6;
                    attn_unit<64>(lds, PROJ + (lrow + qb * 256) * PROJ_N + 416 + qh * 64, PROJ_N, PROJ + crow_ * PROJ_N + 928 + (qh >> 2) * 64, PROJ + lrow * PROJ_N + 928 + (qh >> 2) * 64, PROJ_N,
                                  nullptr, nullptr, 0, PROJ + crow_ * PROJ_N + 1056 + (qh >> 2) * 64, PROJ + lrow * PROJ_N + 1056 + (qh >> 2) * 64, PROJ_N,
                                  Ab + (lrow + qb * 256) * D + 512 + qh * 64, D, lo, hi, true, qb * 256, scB, true, IN(I_SINK)[qh] * LOG2E, 2, ROPE); }
                for (int u = vcu; u < 64; u += G) { const int b = u >> 3, hd = u & 7; const size_t crow_ = (size_t)TL + b * CTXN;
                    attn_unit<96>(lds, QKV + crow_ * QKV_N + hd * 96, QKV_N, QKV + crow_ * QKV_N + 768 + hd * 128, QKV, QKV_N, PROJ + crow_ * PROJ_N + 384, PROJ, PROJ_N,
                                  QKV + crow_ * QKV_N + 832 + hd * 128, QKV, QKV_N, Ab + crow_ * D + hd * 64, D, 0, 0, false, 0, scA, false, 0.f, 0, ROPE);
                    attn_unit<64>(lds, PROJ + crow_ * PROJ_N + 416 + hd * 64, PROJ_N, PROJ + crow_ * PROJ_N + 928 + (hd >> 2) * 64, PROJ, PROJ_N, nullptr, nullptr, 0,
                                  PROJ + crow_ * PROJ_N + 1056 + (hd >> 2) * 64, PROJ, PROJ_N, Ab + crow_ * D + 512 + hd * 64, D, 0, 0, false, 0, scB, true, IN(I_SINK)[hd] * LOG2E, 0, ROPE); }
                }
            }
            GSYNC();
            { pg8::EpiBf16 e{Yb, D}; RUN_GEMM(pg8::EpiBf16, e, Ab, WOUTT, TA, 1024, 1024, 1024, 1024, NOGRP, 0); }
            GSYNC();
        } else {
            { TIDS
            const float* cre = IN(I_CRE); const float* cim = IN(I_CIM); const float* dsk = IN(I_S5D);
            for (int rep_ = 0; rep_ < PROBE_MISC; ++rep_) for (int i0 = gt; i0 < 64 * 1024 * 128; i0 += 4 * ngt) {
                f32x4 a0[4], a1[4], b0[4], b1[4]; float dg[4];
#pragma unroll
                for (int u = 0; u < 4; ++u) { const int i = i0 + u * ngt; if (i < 64 * 1024 * 128) { const int k8 = (i & 127) * 8, n = (i >> 7) & 1023, g = i >> 17, tp = n >> 4, hh = n & 15, sp = k8 >> 4, h0 = k8 & 15, dd = tp - sp, dA = dd > 0 ? dd : 0, dB = dd < 0 ? -dd : 0;
                    const f32x4* ka = (const f32x4*)(KTAB + ((((size_t)g * 2 + 0) * 64 + dA) * 16 + hh) * 16 + h0); const f32x4* kb = (const f32x4*)(KTAB + ((((size_t)g * 2 + 1) * 64 + dB) * 16 + hh) * 16 + h0);
                    a0[u] = ka[0]; a1[u] = ka[1]; b0[u] = kb[0]; b1[u] = kb[1]; dg[u] = (dd == 0) ? dsk[g * 16 + hh] : 0.f; } }
#pragma unroll
                for (int u = 0; u < 4; ++u) { const int i = i0 + u * ngt; if (i < 64 * 1024 * 128) { const int k8 = (i & 127) * 8, n = (i >> 7) & 1023, g = i >> 17, tp = n >> 4, hh = n & 15, sp = k8 >> 4, h0 = k8 & 15, dd = tp - sp; const float wa = dd >= 0 ? 1.f : 0.f, wb = dd <= 0 ? 1.f : 0.f; float v[8];
#pragma unroll
                    for (int j = 0; j < 4; ++j) { v[j] = wa * a0[u][j] + wb * b0[u][j] + ((h0 + j) == hh ? dg[u] : 0.f); v[4 + j] = wa * a1[u][j] + wb * b1[u][j] + ((h0 + 4 + j) == hh ? dg[u] : 0.f); }
                    u32x4 w; w.x = cvtpk(v[0], v[1]); w.y = cvtpk(v[2], v[3]); w.z = cvtpk(v[4], v[5]); w.w = cvtpk(v[6], v[7]); *(u32x4*)(BMm + ((size_t)g * 1024 + n) * XE_K + k8) = w; } } }
            for (int rep_ = 0; rep_ < PROBE_MISC; ++rep_) for (int i = gt; i < 64 * 1024 * 32; i += ngt) { const int kk = (i & 31) * 8, n = (i >> 5) & 1023, g = i >> 15, tp = n >> 4, hh = n & 15, dir = kk >> 7, ri = (kk >> 6) & 1, p0 = kk & 63, e = dir == 0 ? tp + 1 : 64 - tp; float v[8];
#pragma unroll
                for (int j = 0; j < 8; ++j) { const int p = p0 + j; const float pr = POW[(size_t)((dir * 64 + g) * 64 + p) * 130 + 2 * e], pi = POW[(size_t)((dir * 64 + g) * 64 + p) * 130 + 2 * e + 1];
                    const float cr = cre[((size_t)(dir * 64 + g) * 16 + hh) * 64 + p], ci = cim[((size_t)(dir * 64 + g) * 16 + hh) * 64 + p]; v[j] = ri == 0 ? cr * pr - ci * pi : -(cr * pi + ci * pr); }
                u32x4 w; w.x = cvtpk(v[0], v[1]); w.y = cvtpk(v[2], v[3]); w.z = cvtpk(v[4], v[5]); w.w = cvtpk(v[6], v[7]); *(u32x4*)(BMm + ((size_t)g * 1024 + n) * XE_K + 1024 + kk) = w; }
            for (int rep_ = 0; rep_ < PROBE_MISC; ++rep_) for (int i = gt; i < 64 * 256 * 128; i += ngt) { const int k8 = (i & 127) * 8, n = (i >> 7) & 255, g = i >> 15, dir = n >> 7, ri = (n >> 6) & 1, p = n & 63, sp = k8 >> 4, h0 = k8 & 15, e = dir == 0 ? 63 - sp : sp;
                const size_t ib = (size_t)((dir * 64 + g) * 64 + p); const float pr = POW[ib * 130 + 2 * e], pi = POW[ib * 130 + 2 * e + 1]; float v[8];
#pragma unroll
                for (int j = 0; j < 8; ++j) { const float br = BBAR[(ib * 16 + h0 + j) * 2], bi = BBAR[(ib * 16 + h0 + j) * 2 + 1]; v[j] = ri == 0 ? pr * br - pi * bi : pr * bi + pi * br; }
                u32x4 w; w.x = cvtpk(v[0], v[1]); w.y = cvtpk(v[2], v[3]); w.z = cvtpk(v[4], v[5]); w.w = cvtpk(v[6], v[7]); *(u32x4*)(BSm + ((size_t)g * 256 + n) * 1024 + k8) = w; }
            }
            { pg8::EpiS5In e{XE, UC}; RUN_GEMM(pg8::EpiS5In, e, Ab, S5INT, TA, 1024, 1024, 1024, 1024, NOGRP, 0); }
            GSYNC();
            { TIDS
            LAS float* su = (LAS float*)lds;
            for (int rep_ = 0; rep_ < PROBE_MISC; ++rep_) for (int pi0 = bx * 2; pi0 < 512; pi0 += G * 2) {
                __syncthreads();
#pragma unroll
                for (int k = 0; k < 4; ++k) { const int idx = tid + 512 * k, pr = idx >> 10, rem = idx & 1023, j = rem >> 2, q = rem & 3, pi = pi0 + pr;
                    if (pi < 512) ((LAS f32x4*)su)[idx] = *(const f32x4*)(UC + (size_t)((pi >> 6) * 256 + j) * D + (pi & 63) * 16 + 4 * q); }
                __syncthreads();
                if (wave < 4 && pi0 + (wave >> 1) < 512) { const int pi = pi0 + (wave >> 1), dir = wave & 1, b = pi >> 6, g = pi & 63, p = lane; const size_t ib = (size_t)((dir * 64 + g) * 64 + p);
                    const float are = ABAR[2 * ib], aim = ABAR[2 * ib + 1]; float br[16], bi[16];
#pragma unroll
                    for (int hh = 0; hh < 16; ++hh) { br[hh] = BBAR[(ib * 16 + hh) * 2]; bi[hh] = BBAR[(ib * 16 + hh) * 2 + 1]; }
                    float sr = 0.f, si = 0.f; const LAS f32x4* ub = (const LAS f32x4*)su + (wave >> 1) * 1024;
#pragma unroll 4
                    for (int jj = 0; jj < 256; ++jj) { const int j = dir == 0 ? jj : 255 - jj; const LAS f32x4* up = ub + j * 4; float ur = 0.f, ui = 0.f;
#pragma unroll
                        for (int q = 0; q < 4; ++q) { const f32x4 uv = up[q]; ur += uv.x * br[4 * q] + uv.y * br[4 * q + 1] + uv.z * br[4 * q + 2] + uv.w * br[4 * q + 3]; ui += uv.x * bi[4 * q] + uv.y * bi[4 * q + 1] + uv.z * bi[4 * q + 2] + uv.w * bi[4 * q + 3]; }
                        const float nr = are * sr - aim * si + ur, ni = are * si + aim * sr + ui; sr = nr; si = ni; }
                    SCTX[(((size_t)b * 64 + g) * 2 + dir) * 128 + p] = sr; SCTX[(((size_t)b * 64 + g) * 2 + dir) * 128 + 64 + p] = si; }
            }
            __syncthreads();
            }
            { pg8::EpiF32 e{Eb, 256}; RUN_GEMM(pg8::EpiF32, e, XE, BSm, 64 * 1024, 256, 1024, XE_K, 1024, 4, 256 * 1024); }
            GSYNC();
            { TIDS
            for (int rep_ = 0; rep_ < PROBE_MISC; ++rep_) for (int i = gt; i < 8 * 64 * 2 * 64; i += ngt) { const int p = i & 63, dir = (i >> 6) & 1, g = (i >> 7) & 63, b = i >> 13; const size_t ib = (size_t)((dir * 64 + g) * 64 + p);
                const float are = POW[ib * 130 + 128], aim = POW[ib * 130 + 129];
                float sr = SCTX[(((size_t)b * 64 + g) * 2 + dir) * 128 + p], si = SCTX[(((size_t)b * 64 + g) * 2 + dir) * 128 + 64 + p];
                for (int cb = 0; cb < 128; cb += 8) { float er[8], ei[8];
#pragma unroll
                    for (int u = 0; u < 8; ++u) { const int c = dir == 0 ? cb + u : 127 - (cb + u); const size_t row = (size_t)g * 1024 + b * 128 + c; er[u] = Eb[row * 256 + dir * 128 + p]; ei[u] = Eb[row * 256 + dir * 128 + 64 + p]; }
#pragma unroll
                    for (int u = 0; u < 8; ++u) { const int c = dir == 0 ? cb + u : 127 - (cb + u); const size_t row = (size_t)g * 1024 + b * 128 + c;
                        XE[row * XE_K + 1024 + dir * 128 + p] = (bf16_t)f2bf(sr); XE[row * XE_K + 1024 + dir * 128 + 64 + p] = (bf16_t)f2bf(si);
                        const float nr = are * sr - aim * si + er[u], ni = are * si + aim * sr + ei[u]; sr = nr; si = ni; } } }
            }
            GSYNC();
            { pg8::EpiS5Out e{Ab}; RUN_GEMM(pg8::EpiS5Out, e, XE, BMm, 64 * 1024, 1024, XE_K, XE_K, XE_K, 4, 1024 * XE_K); }
            GSYNC();
            { pg8::EpiGlu e{Yb}; RUN_GEMM(pg8::EpiGlu, e, Ab, GLUT, TL, 2048, 1024, 1024, 1024, NOGRP, 0); }
            GSYNC();
        }
        const int nr2 = l == 0 ? TA : TL;
        {
            TIDS
            RowOp o{HB, HCTX, true, HB, HCTX, true, Yb, npost + D, MODL, 5, 1.0f, npre + 2 * D, MODL, 6, 7, Ab, nr2};
            row_phase(o, gw, ngw, lane);
        }
        GSYNC();
        for (int rep_ = 0; rep_ < PROBE_G1; ++rep_) { pg8::EpiSwiglu e{Ub}; RUN_GEMM(pg8::EpiSwiglu, e, Ab, W13T + (size_t)(l * 2 + 1) * 5632 * 1024, nr2, 5632, 1024, 1024, 1024, NOGRP, 0); }
        GSYNC();
        for (int rep_ = 0; rep_ < PROBE_G2; ++rep_) { pg8::EpiBf16 e{Yb, D}; RUN_GEMM(pg8::EpiBf16, e, Ub, W2T + (size_t)(l * 2 + 1) * 1024 * 2816, nr2, 1024, 2816, 2816, 2816, NOGRP, 0); }
        GSYNC();
        {
            TIDS
            RowOp o{HB, HCTX, true, l == 0 ? (void*)HB : (void*)OUT, HCTX, l == 0, Yb, npost + 2 * D, MODL, 8, 0.5f, l == 0 ? IN(I_NPRE) + 3 * D : nullptr, MOD1, 0, 1, Ab, nr2};
            row_phase(o, gw, ngw, lane);
        }
        if (l == 0) GSYNC();
}

__global__ void __launch_bounds__(512, 2) fwd_megakernel(Args args) {
    extern __shared__ __attribute__((aligned(16))) unsigned char lds_raw[];
    LAS unsigned char* lds = (LAS unsigned char*)lds_raw;
    cg::grid_group grid = cg::this_grid();
    {
        if (threadIdx.x < 2) ((LAS unsigned*)(lds + XB_LDS_OFF))[threadIdx.x] = 0u;
        if (blockIdx.x == 0) { GAS unsigned* bw = (GAS unsigned*)args.ws; for (int i = threadIdx.x; i < XCD_BAR_WORDS; i += 512) bw[i] = 0u; }
        __syncthreads();
    }
    for (int rep_ = 0; rep_ < PROBE_MISC * PROBE_PRO; ++rep_) { prologue_phase(args, lds); __syncthreads(); }
    grid.sync();
    if (threadIdx.x == 0) (void)xb_add((unsigned*)args.ws + XB_XCNT(xb_xcc_id()), 1u);
    layer_phase<0>(args, lds, grid);
    layer_phase<1>(args, lds, grid);
}

extern "C" void kernel_launch(void* const* d_in, const int* in_sizes, int n_in, void* d_out, int out_size, void* d_ws, size_t ws_size, hipStream_t stream) {
    static int grid_blocks = 0;
    if (grid_blocks == 0) {
        if (n_in != 27 || out_size != TL * D || ws_size < WS_END) { fprintf(stderr, "kernel_launch: unexpected shapes (n_in %d out %d ws %zu)\n", n_in, out_size, ws_size); grid_blocks = -1; return; }
        int dev = 0, cus = 0, per_cu = 0;
        hipGetDevice(&dev);
        hipDeviceGetAttribute(&cus, hipDeviceAttributeMultiprocessorCount, dev);
        hipFuncSetAttribute((const void*)fwd_megakernel, hipFuncAttributeMaxDynamicSharedMemorySize, LDS_BYTES);
        hipOccupancyMaxActiveBlocksPerMultiprocessor(&per_cu, (const void*)fwd_megakernel, 512, LDS_BYTES);
        if (per_cu < 1) per_cu = 1;
        grid_blocks = cus * per_cu;
        (void)hipGetLastError();
    }
    if (grid_blocks < 0) return;
    Args a{};
    for (int i = 0; i < 27; ++i) a.in[i] = (const float*)d_in[i];
    a.out = (float*)d_out; a.ws = (unsigned char*)d_ws;
    void* kargs[] = {&a};
    hipError_t e = hipLaunchCooperativeKernel((const void*)fwd_megakernel, dim3(grid_blocks), dim3(512), kargs, LDS_BYTES, stream);
    if (e != hipSuccess) fprintf(stderr, "cooperative launch failed: %s (grid %d)\n", hipGetErrorString(e), grid_blocks);
}
```
